# Optimizing an MI355X kernel written in HIP

```python
import jax, jax.numpy as jnp
from jax import lax
import numpy as np

D_MODEL = 1024
BATCH = 16
SEQ = 4096
DEPTH = 2

GRID_W = 64
CTX_LEN = 256
N_MOD = 6
FNET_GROUPS = 8
FNET_GROUP_DIM = 64
FNET_WIDTH = FNET_GROUPS * FNET_GROUP_DIM
RET_HEADS = 8
RET_DK = 64
RET_DV = 64
RET_QK_WIDTH = RET_HEADS * RET_DK
RET_V_WIDTH = RET_HEADS * RET_DV
RET_CHUNK = 128
RET_DECAY_BASE = 5.0
IN_WIDTH = FNET_WIDTH + 2 * RET_QK_WIDTH + 2 * RET_V_WIDTH
IN_SPLITS = (FNET_WIDTH, FNET_WIDTH + RET_QK_WIDTH, FNET_WIDTH + 2 * RET_QK_WIDTH,
             FNET_WIDTH + 2 * RET_QK_WIDTH + RET_V_WIDTH)
MIX_WIDTH = FNET_WIDTH + RET_V_WIDTH
ROPE_BASE = 10000.0
N_EXPERTS = 32
TOP_K = 4
D_EXPERT = D_MODEL
SWIGLU_LIMIT = 7.0
SWIGLU_ALPHA = 1.702
MOE_BLOCK = 128
NORM_EPS = 1e-6

kernel_name = "hybrid_fnet_retention_moe_dit"


def rmsnorm(x, w):
    x32 = x.astype(jnp.float32)
    y = x32 * lax.rsqrt(jnp.mean(x32 * x32, axis=-1, keepdims=True) + NORM_EPS)
    return (y * w.astype(jnp.float32)).astype(x.dtype)


def modulate(h, shift, scale):
    return h * (1 + scale) + shift


def flip(t):
    return jnp.flip(t, axis=1)


def heads(t, d):
    return t.reshape(t.shape[0], t.shape[1], RET_HEADS, d)


def axial_rope_angles(rows):
    row = jnp.broadcast_to(jnp.arange(rows)[:, None], (rows, GRID_W)).reshape(-1).astype(jnp.float32)
    col = jnp.broadcast_to(jnp.arange(GRID_W)[None, :], (rows, GRID_W)).reshape(-1).astype(jnp.float32)
    n_freq = RET_DK // 4
    freqs = ROPE_BASE ** (-jnp.arange(n_freq, dtype=jnp.float32) / n_freq)
    return jnp.concatenate([row[:, None] * freqs, col[:, None] * freqs], axis=-1)


def apply_rope(t, ang):
    cos = jnp.cos(ang)[None, :, None, :]
    sin = jnp.sin(ang)[None, :, None, :]
    t1, t2 = jnp.split(t, 2, axis=-1)
    return jnp.concatenate([t1 * cos - t2 * sin, t1 * sin + t2 * cos], axis=-1).astype(t.dtype)


def fourier_mix(z):
    b, t, _ = z.shape
    zg = z.reshape(b, t, FNET_GROUPS, FNET_GROUP_DIM).astype(jnp.float32)
    y = jnp.fft.fft2(zg, axes=(1, 3), norm="ortho").real
    return y.reshape(b, t, FNET_WIDTH)


def retention_states(k, v, log_g, s0):
    b, t, h, dk = k.shape
    n = t // RET_CHUNK
    kc = k.reshape(b, n, RET_CHUNK, h, dk)
    vc = v.reshape(b, n, RET_CHUNK, h, v.shape[-1])
    j = jnp.arange(RET_CHUNK, dtype=jnp.float32)
    w_kv = jnp.exp((RET_CHUNK - 1 - j)[:, None] * log_g[None, :])
    chunk_kv = jnp.einsum('bnjhd,jh,bnjhe->nbhde', kc, w_kv, vc)
    g_chunk = jnp.exp(RET_CHUNK * log_g)[None, :, None, None]

    def step(s, kv):
        return g_chunk * s + kv, s

    s_final, s_before = lax.scan(step, s0, chunk_kv)
    return s_before, s_final


def retention_outputs(q, k, v, log_g, s_before):
    b, t, h, dk = q.shape
    n = t // RET_CHUNK
    qc = q.reshape(b, n, RET_CHUNK, h, dk)
    kc = k.reshape(b, n, RET_CHUNK, h, dk)
    vc = v.reshape(b, n, RET_CHUNK, h, v.shape[-1])
    pos = jnp.arange(RET_CHUNK)
    diff = pos[:, None] - pos[None, :]
    decay = jnp.where((diff >= 0)[None],
                      jnp.exp(jnp.maximum(diff, 0).astype(jnp.float32)[None] * log_g[:, None, None]),
                      0.0)
    scores = jnp.einsum('bnihd,bnjhd->bnhij', qc, kc) * decay
    o_intra = jnp.einsum('bnhij,bnjhe->bnihe', scores, vc)
    w_q = jnp.exp((pos.astype(jnp.float32) + 1.0)[:, None] * log_g[None, :])
    o_cross = jnp.einsum('bnihd,ih,nbhde->bnihe', qc, w_q, s_before)
    return (o_intra + o_cross).reshape(b, t, h, -1)


def mixer_merge(f_in, o_ret, g, ret_norm_w, w_out, dtype):
    b, t = o_ret.shape[:2]
    o = o_ret.astype(jnp.float32)
    mu = jnp.mean(o, axis=-1, keepdims=True)
    var = jnp.mean(jnp.square(o - mu), axis=-1, keepdims=True)
    on = ((o - mu) * lax.rsqrt(var + NORM_EPS)).reshape(b, t, RET_V_WIDTH)
    y = jax.nn.silu(g.astype(jnp.float32)) * on * ret_norm_w.astype(jnp.float32)
    cat = jnp.concatenate([fourier_mix(f_in), y], axis=-1).astype(dtype)
    return cat @ w_out


def moe_ffn(h, router_w, router_b, w1, b1, w2, b2):
    n_tok, d = h.shape
    n_assign = n_tok * TOP_K
    logits = (h @ router_w + router_b).astype(jnp.float32)
    top_vals, top_idx = lax.top_k(logits, TOP_K)
    gates = jax.nn.softmax(top_vals, axis=-1)
    flat_e = top_idx.reshape(-1)
    flat_tok = jnp.arange(n_assign) // TOP_K
    order = jnp.argsort(flat_e)
    sorted_e = flat_e[order]
    sorted_tok = flat_tok[order]
    sorted_gate = gates.reshape(-1)[order]
    group_sizes = jnp.bincount(flat_e, length=N_EXPERTS)
    padded_sizes = (group_sizes + MOE_BLOCK - 1) // MOE_BLOCK * MOE_BLOCK
    group_start = jnp.cumsum(group_sizes) - group_sizes
    padded_end = jnp.cumsum(padded_sizes)
    padded_start = padded_end - padded_sizes
    dest = padded_start[sorted_e] + (jnp.arange(n_assign) - group_start[sorted_e])
    n_blocks = -(-n_assign // MOE_BLOCK) + N_EXPERTS
    buf = jnp.zeros((n_blocks * MOE_BLOCK, d), h.dtype).at[dest].set(h[sorted_tok])
    block_e = jnp.minimum(jnp.searchsorted(padded_end, jnp.arange(n_blocks) * MOE_BLOCK, side='right'),
                          N_EXPERTS - 1)

    def expert_block(args):
        xb, e = args
        hb = xb @ w1[e] + b1[e]
        x_glu = jnp.minimum(hb[:, ::2], SWIGLU_LIMIT)
        x_lin = jnp.clip(hb[:, 1::2], -SWIGLU_LIMIT, SWIGLU_LIMIT)
        act = x_glu * jax.nn.sigmoid(SWIGLU_ALPHA * x_glu) * (x_lin + 1)
        return act @ w2[e] + b2[e]

    out = lax.map(expert_block, (buf.reshape(n_blocks, MOE_BLOCK, d), block_e)).reshape(-1, d)
    contrib = out[dest].astype(jnp.float32) * sorted_gate[:, None]
    return jax.ops.segment_sum(contrib, sorted_tok, num_segments=n_tok).astype(h.dtype)


def setup_inputs(seed: int = 0) -> dict:
    key = jax.random.key(seed)
    ks = jax.random.split(key, 19)
    f32 = jnp.float32
    nrm = lambda k, shape, s: jax.random.normal(k, shape, f32) * s
    return {
        "x": nrm(ks[0], (BATCH, SEQ, D_MODEL), 1.0),
        "c": nrm(ks[1], (BATCH, D_MODEL), 1.0),
        "ctx": nrm(ks[2], (BATCH, CTX_LEN, D_MODEL), 1.0),
        "c_ctx": nrm(ks[3], (D_MODEL,), 1.0),
        "mod_w": nrm(ks[4], (DEPTH, D_MODEL, N_MOD * D_MODEL), 0.5 * D_MODEL ** -0.5),
        "mod_b": nrm(ks[5], (DEPTH, N_MOD * D_MODEL), 0.01),
        "norm_w": 1.0 + nrm(ks[6], (DEPTH, 2, D_MODEL), 0.01),
        "w_in": nrm(ks[7], (DEPTH, D_MODEL, IN_WIDTH), D_MODEL ** -0.5),
        "w_out": nrm(ks[8], (DEPTH, MIX_WIDTH, D_MODEL), MIX_WIDTH ** -0.5),
        "ret_decay": RET_DECAY_BASE + jnp.arange(RET_HEADS, dtype=f32) + nrm(ks[9], (DEPTH, 2, RET_HEADS), 0.05),
        "ret_norm_w": 1.0 + nrm(ks[10], (DEPTH, RET_V_WIDTH), 0.01),
        "router_w": nrm(ks[11], (DEPTH, D_MODEL, N_EXPERTS), D_MODEL ** -0.5),
        "router_b": nrm(ks[12], (DEPTH, N_EXPERTS), 0.01),
        "expert_w1": nrm(ks[13], (DEPTH, N_EXPERTS, D_MODEL, 2 * D_EXPERT), D_MODEL ** -0.5),
        "expert_b1": nrm(ks[14], (DEPTH, N_EXPERTS, 2 * D_EXPERT), 0.01),
        "expert_w2": nrm(ks[15], (DEPTH, N_EXPERTS, D_EXPERT, D_MODEL), D_EXPERT ** -0.5),
        "expert_b2": nrm(ks[16], (DEPTH, N_EXPERTS, D_MODEL), 0.01),
        "final_norm_w": 1.0 + nrm(ks[17], (D_MODEL,), 0.01),
    }


def reference(x, c, ctx, c_ctx, mod_w, mod_b, norm_w, w_in, w_out, ret_decay, ret_norm_w,
              router_w, router_b, expert_w1, expert_b1, expert_w2, expert_b2, final_norm_w):
    b, n_lat, d = x.shape
    rows = n_lat // GRID_W
    ang = axial_rope_angles(rows)
    s0 = jnp.zeros((b, RET_HEADS, RET_DK, RET_DV), jnp.float32)
    q_scale = RET_DK ** -0.5
    for l in range(DEPTH):
        has_ctx_out = l < DEPTH - 1
        mod_x = jnp.split((jax.nn.silu(c) @ mod_w[l] + mod_b[l])[:, None, :], N_MOD, axis=-1)
        mod_c = jnp.split(jax.nn.silu(c_ctx) @ mod_w[l] + mod_b[l], N_MOD, axis=-1)
        log_g = jnp.log1p(-jnp.exp2(-ret_decay[l].astype(jnp.float32)))

        hx = modulate(rmsnorm(x, norm_w[l, 0]), mod_x[0], mod_x[1])
        hc = modulate(rmsnorm(ctx, norm_w[l, 0]), mod_c[0], mod_c[1])
        fx, qx, kx, vx, gx = jnp.split(hx @ w_in[l], IN_SPLITS, axis=-1)
        fc, qc, kc, vc, gc = jnp.split(hc @ w_in[l], IN_SPLITS, axis=-1)
        qx = apply_rope(heads(qx, RET_DK) * q_scale, ang)
        kx = apply_rope(heads(kx, RET_DK), ang)
        vx = heads(vx, RET_DV)
        qc, kc, vc = heads(qc, RET_DK) * q_scale, heads(kc, RET_DK), heads(vc, RET_DV)

        sb_cf, s_cf = retention_states(kc, vc, log_g[0], s0)
        sb_cb, s_cb = retention_states(flip(kc), flip(vc), log_g[1], s0)
        sb_xf, _ = retention_states(kx, vx, log_g[0], s_cf)
        sb_xb, _ = retention_states(flip(kx), flip(vx), log_g[1], s_cb)
        o_x = (retention_outputs(qx, kx, vx, log_g[0], sb_xf)
               + flip(retention_outputs(flip(qx), flip(kx), flip(vx), log_g[1], sb_xb)))
        x = x + mod_x[2] * mixer_merge(fx, o_x, gx, ret_norm_w[l], w_out[l], x.dtype)
        if has_ctx_out:
            o_c = (retention_outputs(qc, kc, vc, log_g[0], sb_cf)
                   + flip(retention_outputs(flip(qc), flip(kc), flip(vc), log_g[1], sb_cb)))
            ctx = ctx + mod_c[2] * mixer_merge(fc, o_c, gc, ret_norm_w[l], w_out[l], ctx.dtype)

        hx = modulate(rmsnorm(x, norm_w[l, 1]), mod_x[3], mod_x[4])
        moe_args = (router_w[l], router_b[l], expert_w1[l], expert_b1[l], expert_w2[l], expert_b2[l])
        if has_ctx_out:
            hc = modulate(rmsnorm(ctx, norm_w[l, 1]), mod_c[3], mod_c[4])
            n_ctx_tok = hc.shape[0] * hc.shape[1]
            y = moe_ffn(jnp.concatenate([hc.reshape(-1, d), hx.reshape(-1, d)], axis=0), *moe_args)
            ctx = ctx + mod_c[5] * y[:n_ctx_tok].reshape(ctx.shape)
            x = x + mod_x[5] * y[n_ctx_tok:].reshape(x.shape)
        else:
            x = x + mod_x[5] * moe_ffn(hx.reshape(-1, d), *moe_args).reshape(x.shape)
    return rmsnorm(x, final_norm_w)
```

```cpp
#include <hip/hip_runtime.h>
#include <cstdio>
#include <cstdint>

#define LAS __attribute__((address_space(3)))
#define GAS __attribute__((address_space(1)))
typedef unsigned short bf16;
typedef short bf16x8 __attribute__((ext_vector_type(8)));
typedef float f32x4 __attribute__((ext_vector_type(4)));
typedef float f32x2 __attribute__((ext_vector_type(2)));
typedef unsigned u32x4 __attribute__((ext_vector_type(4)));
typedef unsigned u32x2 __attribute__((ext_vector_type(2)));

#ifndef DBG
#define DBG 0
#endif
#ifndef PHMASK
#define PHMASK 0xFFFF
#endif
#define PH(k) ((PHMASK >> (k)) & 1)

constexpr int DM = 1024, NB = 16, TL = 4096, TCX = 256;
constexpr int NCTX = NB * TCX, NLAT = NB * TL, MT = NCTX + NLAT;
constexpr int NQ = 2048;
constexpr int NE = 32;
constexpr int MAXTILES = 1120, MAXROWS = MAXTILES * 256;
constexpr float NORM_EPS = 1e-6f;

constexpr size_t MiB = 1u << 20;
constexpr size_t WS_CTL = 0, CTL_ZERO_BYTES = 1 * MiB;
constexpr size_t WS_WQ = 1 * MiB;
constexpr size_t WS_WF = 9 * MiB;
constexpr size_t WS_WO = 13 * MiB;
constexpr size_t WS_W1 = 17 * MiB;
constexpr size_t WS_W2 = 273 * MiB;
constexpr size_t WS_DFT = 401 * MiB;
constexpr size_t WS_DFTC = 465 * MiB;
constexpr size_t WS_MODP = 466 * MiB;
constexpr size_t WS_MODV = 473 * MiB;
constexpr size_t WS_A12 = 474 * MiB;
constexpr size_t WS_ROPE = 475 * MiB;
constexpr size_t WS_TOPE = 476 * MiB;
constexpr size_t WS_TOPG = 478 * MiB;
constexpr size_t WS_DEST = 480 * MiB;
constexpr size_t WS_ROWMAP = 482 * MiB;
constexpr size_t WS_TILEE = 484 * MiB;
constexpr size_t WS_XCTX = 485 * MiB;
constexpr size_t WS_H = 501 * MiB;
constexpr size_t WS_MIX = 637 * MiB;
constexpr size_t WS_QKVG = WS_MIX;
constexpr size_t WS_ZT = WS_MIX + 272 * MiB;
constexpr size_t WS_ZTC = WS_MIX + 400 * MiB;
constexpr size_t WS_OF = WS_MIX + 408 * MiB;
constexpr size_t WS_OB = WS_MIX + 476 * MiB;
constexpr size_t WS_CAT = WS_MIX + 544 * MiB;
constexpr size_t WS_ACT = WS_MIX;
constexpr size_t WS_EOUT = 1317 * MiB;
constexpr size_t WS_END = 1877 * MiB;
static_assert(WS_CAT + (size_t)MT * 1024 * 2 <= WS_EOUT && WS_ACT + (size_t)MAXROWS * 1024 * 2 <= WS_EOUT, "ws map");

constexpr int CW_BAR = 4096;
constexpr int CW_CNT = 8192;
constexpr int CW_CUR = 8448;
constexpr int CW_NT = 8704;
constexpr int CW_CHK = 9216;

constexpr int LDS_BYTES = 155648;
constexpr int LDS_MISC = 155648 - 256;

__device__ __forceinline__ unsigned cvt_pk_bf16(float lo, float hi) { unsigned r; asm volatile("v_cvt_pk_bf16_f32 %0, %1, %2" : "=v"(r) : "v"(lo), "v"(hi)); return r; }
__device__ __forceinline__ float bf_lo(unsigned w) { return __uint_as_float(w << 16); }
__device__ __forceinline__ float bf_hi(unsigned w) { return __uint_as_float(w & 0xffff0000u); }
__device__ __forceinline__ float bf2f(bf16 b) { return __uint_as_float(((unsigned)b) << 16); }
__device__ __forceinline__ float wave_sum(float v) {
#pragma unroll
    for (int o = 1; o < 64; o <<= 1) v += __shfl_xor(v, o);
    return v;
}
__device__ __forceinline__ unsigned lds_add(LAS unsigned* p, unsigned v) { return __hip_atomic_fetch_add(p, v, __ATOMIC_RELAXED, __HIP_MEMORY_SCOPE_WORKGROUP); }
#define LDS_WAIT() asm volatile("s_waitcnt lgkmcnt(0)" ::: "memory")
#define VM_WAIT() asm volatile("s_waitcnt vmcnt(0)" ::: "memory")

#define XB_TMO      128
#define XB_XCNT(j)  (256  + 64 * (j))
#define XB_XSUB(j)  (1280 + 64 * (j))
#define XB_XGEN(j)  (2304 + 64 * (j))
#define XB_TOP      3328
#define XB_TOPGEN   3392
#define XCD_BAR_WORDS 3456
#define XB_SPIN_CAP (1u << 18)

__device__ __forceinline__ unsigned xb_ld(unsigned* p)              { return __hip_atomic_load(p, __ATOMIC_RELAXED, __HIP_MEMORY_SCOPE_AGENT); }
__device__ __forceinline__ unsigned xb_add(unsigned* p, unsigned v) { return __hip_atomic_fetch_add(p, v, __ATOMIC_RELAXED, __HIP_MEMORY_SCOPE_AGENT); }
__device__ __forceinline__ unsigned xb_xcc_id() { return (unsigned)__builtin_amdgcn_s_getreg((3 << 11) | 20) & 0xFu; }
#define XB_SPIN(cond, bar) do { unsigned _sp = 0; while (cond) { __builtin_amdgcn_s_sleep(1); \
    if ((++_sp & 255u) == 0u) { if (xb_ld(&(bar)[XB_TMO])) break; if (_sp > XB_SPIN_CAP) { atomicAdd(&(bar)[XB_TMO], 1u); break; } } } } while (0)

struct XcdBarrier {
    unsigned* bar; unsigned x;
    volatile LAS unsigned* st;
};
__device__ __forceinline__ XcdBarrier xcd_barrier_post(unsigned* bar, volatile LAS unsigned* st) {
    XcdBarrier b; b.bar = bar; b.x = xb_xcc_id(); b.st = st;
    if (threadIdx.x == 0) (void)xb_add(&bar[XB_XCNT(b.x)], 1u);
    return b;
}
__device__ __forceinline__ void xcd_barrier_complete(unsigned* bar, unsigned x, unsigned& nloc, unsigned& nx) {
    const unsigned G = gridDim.x * gridDim.y * gridDim.z;
    unsigned sum, cnt, mine, sp = 0u;
    for (;;) {
        sum = 0u; cnt = 0u; mine = 0u;
#pragma unroll
        for (unsigned j = 0; j < 16; ++j) { const unsigned c = xb_ld(&bar[XB_XCNT(j)]); sum += c; cnt += (c > 0u) ? 1u : 0u; mine = (j == x) ? c : mine; }
        if (sum == G) break;
        __builtin_amdgcn_s_sleep(1);
        if ((++sp & 255u) == 0u) { if (xb_ld(&bar[XB_TMO])) break; if (sp > XB_SPIN_CAP) { atomicAdd(&bar[XB_TMO], 1u); break; } }
    }
    nloc = mine > 0u ? mine : 1u; nx = cnt > 0u ? cnt : 1u;
}
__device__ __forceinline__ void xcd_barrier(const XcdBarrier& b) {
    asm volatile("s_waitcnt vmcnt(0)" ::: "memory");
    __syncthreads();
    if (threadIdx.x == 0) {
        unsigned* bar = b.bar;
        __builtin_amdgcn_s_waitcnt(0);
        unsigned nloc = b.st[0], nx = b.st[1];
        if (nloc == 0u) { xcd_barrier_complete(bar, b.x, nloc, nx); b.st[0] = nloc; b.st[1] = nx; }
        const unsigned old = xb_add(&bar[XB_XSUB(b.x)], 1u);
        const unsigned gen = old / nloc;
        if (old + 1u == (gen + 1u) * nloc) {
            __builtin_amdgcn_fence(__ATOMIC_RELEASE, "agent");
            asm volatile("s_waitcnt vmcnt(0)" ::: "memory");
            const unsigned og = xb_add(&bar[XB_TOP], 1u);
            const unsigned tg = og / nx;
            if (og + 1u == (tg + 1u) * nx) xb_add(&bar[XB_TOPGEN], 1u);
            else XB_SPIN(xb_ld(&bar[XB_TOPGEN]) == tg, bar);
            __builtin_amdgcn_fence(__ATOMIC_ACQUIRE, "agent");
            xb_add(&bar[XB_XGEN(b.x)], 1u);
            asm volatile("s_waitcnt vmcnt(0)" ::: "memory");
        } else {
            XB_SPIN(xb_ld(&bar[XB_XGEN(b.x)]) == gen, bar);
            __builtin_amdgcn_fence(__ATOMIC_ACQUIRE, "agent");
            asm volatile("s_waitcnt vmcnt(0)" ::: "memory");
        }
    }
    __syncthreads();
}

namespace pg8 {
constexpr int BM = 256, BK = 64, HALF = 128, HTB = HALF * BK * 2, STAGE_BYTES = 8 * HTB, NXCD = 8, WGM = 8;
__host__ __device__ __forceinline__ int lds_byte(int r, int c) { const int st = (r >> 4) * 2 + (c >> 5), rr = r & 15, cc = c & 31, ob = rr * 64 + cc * 2; return st * 1024 + (ob ^ (((ob >> 9) & 1) << 5)); }
__host__ __device__ __forceinline__ void stage_rc(int b, int& R, int& C) { const int st = b / 1024, sb = b % 1024, swz = sb ^ (((sb >> 9) & 1) << 5); R = (st >> 1) * 16 + swz / 64; C = (st & 1) * 32 + (swz % 64) / 2; }
__host__ __device__ __forceinline__ int perm32(int rho) { const int n = rho >> 4, i = rho & 15; return 8 * (i >> 2) + 4 * n + (i & 3); }

struct Unit { const char* A; const char* B; int pm, pn, e; };

__device__ __forceinline__ void tile_of(int L, int nM, int nN, int& pm, int& pn) {
    const int nwg = nM * nN; int wgid = L;
    { const int q = nwg / NXCD, r = nwg % NXCD, xcd = wgid % NXCD, off = wgid / NXCD; wgid = (xcd < r ? xcd * (q + 1) : r * (q + 1) + (xcd - r) * q) + off; }
    const int nig = WGM * nN, gid = wgid / nig, fm = gid * WGM, gsz = (nM - fm) < WGM ? (nM - fm) : WGM;
    pm = fm + ((wgid % nig) % gsz); pn = (wgid % nig) / gsz;
}

template <class Epi, class Sched, bool GATHER, bool ALIGN_EPI>
__device__ __forceinline__ void gemm_phase(LAS unsigned char* lds, const int K, const Sched& S, const Epi& E) {
    int tid_ = threadIdx.x; asm volatile("" : "+v"(tid_));
    const int tid = tid_, wid = __builtin_amdgcn_readfirstlane(tid >> 6), lane = tid & 63, wr = wid >> 2, wc = wid & 3, fr = lane & 15, fq = lane >> 4;
    const int nt = K / BK;
    unsigned voffB[2], cAo[2][2], nAo[2][2]; int Rl[2], Cl[2];
#pragma unroll
    for (int i = 0; i < 2; ++i) { int R, C; stage_rc(tid * 16 + i * 8192, R, C); Rl[i] = R; Cl[i] = C; const int Rb = Epi::PERM ? ((R & ~31) + perm32(R & 31)) : R;
        voffB[i] = (unsigned)(Rb * K + C) * 2u; cAo[0][i] = (unsigned)(R * K + C) * 2u; cAo[1][i] = (unsigned)((R + HALF) * K + C) * 2u; nAo[0][i] = cAo[0][i]; nAo[1][i] = cAo[1][i]; }
    const size_t kstep = (size_t)(BK * 2);
    const size_t hstep = (size_t)HALF * K * 2;
    const unsigned ldsw = (unsigned)wid * 1024u;
    const int aoff = lds_byte(wr * 64 + fr, fq * 8), boff = lds_byte(wc * 32 + fr, fq * 8);
#define PG8_SA(b, h) (((b) * 2 + (h)) * HTB)
#define PG8_SB(b, h) ((4 + (b) * 2 + (h)) * HTB)
#define PG8_STAGE_B(bufoff, gbase) do { _Pragma("unroll") for (int _i = 0; _i < 2; ++_i) \
        __builtin_amdgcn_global_load_lds((const unsigned*)((const char*)(gbase) + voffB[_i]), (LAS unsigned*)(lds + (bufoff) + ldsw + _i * 8192), 16, 0, 0); } while (0)
#define PG8_STAGE_A(bufoff, gbase, offs, h) do { _Pragma("unroll") for (int _i = 0; _i < 2; ++_i) \
        __builtin_amdgcn_global_load_lds((const unsigned*)((const char*)(gbase) + (offs)[h][_i]), (LAS unsigned*)(lds + (bufoff) + ldsw + _i * 8192), 16, 0, 0); } while (0)
#define PG8_LDA(dst, b, h) do { _Pragma("unroll") for (int m = 0; m < 4; ++m) _Pragma("unroll") for (int k = 0; k < 2; ++k) dst[m][k] = *(const LAS bf16x8*)(lds + PG8_SA(b, h) + aoff + m * 2048 + k * 1024); } while (0)
#define PG8_LDB(dst, b, h) do { _Pragma("unroll") for (int n = 0; n < 2; ++n) _Pragma("unroll") for (int k = 0; k < 2; ++k) dst[n][k] = *(const LAS bf16x8*)(lds + PG8_SB(b, h) + boff + n * 2048 + k * 1024); } while (0)
#define PG8_MMA(ai, bj, At, Bt) do { __builtin_amdgcn_s_setprio(1); _Pragma("unroll") for (int m = 0; m < 4; ++m) _Pragma("unroll") for (int n = 0; n < 2; ++n) _Pragma("unroll") for (int k = 0; k < 2; ++k) \
        acc[ai][bj][m][n] = __builtin_amdgcn_mfma_f32_16x16x32_bf16(Bt[n][k], At[m][k], acc[ai][bj][m][n], 0, 0, 0); __builtin_amdgcn_s_setprio(0); } while (0)
#define PG8_WAIT_V(n) asm volatile("s_waitcnt vmcnt(" #n ")" ::: "memory")
#define PG8_WAIT_L(n) asm volatile("s_waitcnt lgkmcnt(" #n ")" ::: "memory")
#define PG8_BAR __builtin_amdgcn_s_barrier()
#define PG8_SCHED __builtin_amdgcn_sched_barrier(0)
    Unit cur, nxt; int ui = 0;
    if (!S.next(0, cur)) return;
    if constexpr (GATHER) S.rowoffs(cur, Rl, Cl, cAo);
    f32x4 acc[2][2][4][2];
#pragma unroll
    for (int a = 0; a < 2; ++a)
#pragma unroll
        for (int b = 0; b < 2; ++b)
#pragma unroll
            for (int m = 0; m < 4; ++m)
#pragma unroll
                for (int n = 0; n < 2; ++n) acc[a][b][m][n] = (f32x4){0.f, 0.f, 0.f, 0.f};
    bf16x8 At[4][2], B0[2][2], B1[2][2];
    const char* cA = cur.A; const char* cB = cur.B;
    PG8_STAGE_B(PG8_SB(0, 0), cB); PG8_STAGE_B(PG8_SB(0, 1), cB + hstep); PG8_STAGE_A(PG8_SA(0, 0), cA, cAo, 0); PG8_STAGE_A(PG8_SA(0, 1), cA, cAo, 1);
    if (wr == 1) PG8_BAR;
    PG8_WAIT_V(2); PG8_BAR;
    PG8_STAGE_B(PG8_SB(1, 0), cB + kstep); PG8_STAGE_A(PG8_SA(1, 0), cA + kstep, cAo, 0); PG8_STAGE_B(PG8_SB(1, 1), cB + hstep + kstep);
    PG8_WAIT_V(6); PG8_BAR;
    for (;;) {
        const bool has_next = S.next(ui + 1, nxt);
        const char* nA = has_next ? nxt.A : cA; const char* nB = has_next ? nxt.B : cB;
        if constexpr (GATHER) { if (has_next) S.rowoffs(nxt, Rl, Cl, nAo); else { nAo[0][0] = cAo[0][0]; nAo[0][1] = cAo[0][1]; nAo[1][0] = cAo[1][0]; nAo[1][1] = cAo[1][1]; } }
        for (int t = 0; t < nt; t += 2) {
            const bool last = (t == nt - 2);
            const char* a1 = cA + (size_t)(t + 1) * kstep;
            const char* a2 = last ? nA : cA + (size_t)(t + 2) * kstep; const char* b2 = last ? nB : cB + (size_t)(t + 2) * kstep;
            const char* a3 = a2 + kstep; const char* b3 = b2 + kstep;
            unsigned o2[2][2];
#pragma unroll
            for (int h = 0; h < 2; ++h)
#pragma unroll
                for (int i = 0; i < 2; ++i) o2[h][i] = (GATHER && last) ? nAo[h][i] : cAo[h][i];
            PG8_LDB(B0, 0, 0); PG8_LDB(B1, 0, 1); PG8_SCHED; PG8_LDA(At, 0, 0); PG8_STAGE_A(PG8_SA(1, 1), a1, cAo, 1);
            PG8_WAIT_V(8); PG8_WAIT_L(0); PG8_BAR; PG8_MMA(0, 0, At, B0); PG8_MMA(0, 1, At, B1); PG8_BAR; PG8_SCHED;
            PG8_LDA(At, 0, 1); PG8_STAGE_B(PG8_SB(0, 0), b2); PG8_STAGE_B(PG8_SB(0, 1), b2 + hstep); PG8_STAGE_A(PG8_SA(0, 0), a2, o2, 0);
            PG8_WAIT_V(8); PG8_WAIT_L(0); PG8_BAR; PG8_MMA(1, 0, At, B0); PG8_MMA(1, 1, At, B1); PG8_BAR; PG8_SCHED;
            PG8_LDB(B0, 1, 0); PG8_LDB(B1, 1, 1); PG8_SCHED; PG8_LDA(At, 1, 0); PG8_STAGE_A(PG8_SA(0, 1), a2, o2, 1);
            PG8_WAIT_V(8); PG8_WAIT_L(0); PG8_BAR; PG8_MMA(0, 0, At, B0); PG8_MMA(0, 1, At, B1); PG8_BAR; PG8_SCHED;
            PG8_LDA(At, 1, 1); PG8_STAGE_B(PG8_SB(1, 0), b3); PG8_STAGE_B(PG8_SB(1, 1), b3 + hstep); PG8_STAGE_A(PG8_SA(1, 0), a3, o2, 0);
            PG8_WAIT_V(8); PG8_WAIT_L(0); PG8_BAR; PG8_MMA(1, 0, At, B0); PG8_MMA(1, 1, At, B1); PG8_BAR; PG8_SCHED;
        }
        if constexpr (ALIGN_EPI) { if (wr == 0) PG8_BAR; }
        E(acc, cur, wr, wc, fr, fq);
        if (!has_next) break;
#pragma unroll
        for (int a = 0; a < 2; ++a)
#pragma unroll
            for (int b = 0; b < 2; ++b)
#pragma unroll
                for (int m = 0; m < 4; ++m)
#pragma unroll
                    for (int n = 0; n < 2; ++n) acc[a][b][m][n] = (f32x4){0.f, 0.f, 0.f, 0.f};
        cur = nxt; cA = nA; cB = nB; ++ui;
        if constexpr (GATHER) { cAo[0][0] = nAo[0][0]; cAo[0][1] = nAo[0][1]; cAo[1][0] = nAo[1][0]; cAo[1][1] = nAo[1][1]; }
        if constexpr (ALIGN_EPI) { if (wr == 1) PG8_BAR; }
    }
    PG8_WAIT_V(0);
    if constexpr (!ALIGN_EPI) { if (wr == 0) PG8_BAR; }
    PG8_BAR;
#undef PG8_SA
#undef PG8_SB
#undef PG8_STAGE_A
#undef PG8_STAGE_B
#undef PG8_LDA
#undef PG8_LDB
#undef PG8_MMA
#undef PG8_WAIT_V
#undef PG8_WAIT_L
#undef PG8_BAR
#undef PG8_SCHED
}
}
using pg8::Unit;
typedef const f32x4 (&AccRef)[2][2][4][2];

struct Args { const float* in[18]; float* out; unsigned char* ws; };
enum { I_X = 0, I_C, I_CTX, I_CCTX, I_MODW, I_MODB, I_NORMW, I_WIN, I_WOUT, I_DECAY, I_RNW, I_RW, I_RB, I_W1, I_B1, I_W2, I_B2, I_FNW };

struct Frame {
    LAS unsigned char* lds;
    unsigned char* ws;
    unsigned* ctl;
    int tid, lane, wave, G, c;
};
__device__ __forceinline__ int batch_of_row(int r) { return r < NCTX ? 16 : ((r - NCTX) >> 12); }

struct SchedReg {
    const char* A; const char* B; int nM, nN, pm0, G, c; size_t tstep;
    __device__ __forceinline__ bool next(int i, Unit& u) const {
        const int L = i * G + c; if (L >= nM * nN) return false;
        int pm, pn; pg8::tile_of(L, nM, nN, pm, pn); u.pm = pm + pm0; u.pn = pn; u.e = 0;
        u.A = A + (size_t)u.pm * tstep; u.B = B + (size_t)pn * tstep; return true; }
};
struct SchedInproj {
    const char* H; const char* Wq; const char* Wf; int G, c;
    __device__ __forceinline__ bool next(int i, Unit& u) const {
        const int L = i * G + c; constexpr size_t tstep = (size_t)256 * 1024 * 2;
        if (L >= 3264) return false;
        int pm, pn;
        if (L < 2176) { pg8::tile_of(L, 272, 8, pm, pn); u.e = 0; u.A = H + (size_t)pm * tstep; u.B = Wq + (size_t)pn * tstep; }
        else { pg8::tile_of(L - 2176, 4, 272, pm, pn); u.e = 1; u.A = Wf + (size_t)pm * tstep; u.B = H + (size_t)pn * tstep; }
        u.pm = pm; u.pn = pn; return true; }
};
struct SchedDft {
    const char* Dm; const char* ZT; int G, c;
    __device__ __forceinline__ bool next(int i, Unit& u) const {
        const int L = i * G + c; if (L >= 512) return false;
        const int pm = L & 15, bp = L >> 4, b = bp >> 1, pn = bp & 1; constexpr size_t tstep = (size_t)256 * 8192 * 2;
        u.pm = pm; u.pn = pn; u.e = b; u.A = Dm + (size_t)pm * tstep; u.B = ZT + (size_t)b * ((size_t)512 * 8192 * 2) + (size_t)pn * tstep; return true; }
};
struct SchedDftC {
    const char* Dm; const char* ZT; int G, c;
    __device__ __forceinline__ bool next(int i, Unit& u) const {
        const int L = i * G + c; if (L >= 32) return false;
        const int b = L >> 1, pn = L & 1;
        u.pm = 0; u.pn = pn; u.e = b; u.A = Dm; u.B = ZT + (size_t)b * ((size_t)512 * 512 * 2) + (size_t)pn * ((size_t)256 * 512 * 2); return true; }
};
struct SchedMoe {
    const char* A; const char* B; const int* tile_e; const int* rowmap; int nT, nN, G, c; size_t strideE;
    __device__ __forceinline__ bool next(int i, Unit& u) const {
        const int L = i * G + c; if (L >= nT * nN) return false;
        int pm, pn; pg8::tile_of(L, nT, nN, pm, pn); constexpr size_t tstep = (size_t)256 * 1024 * 2;
        const int e = __builtin_amdgcn_readfirstlane(tile_e[pm]);
        u.pm = pm; u.pn = pn; u.e = e; u.A = A + (rowmap ? (size_t)0 : (size_t)pm * tstep); u.B = B + (size_t)e * strideE + (size_t)pn * tstep; return true; }
    __device__ __forceinline__ void rowoffs(const Unit& u, const int (&Rl)[2], const int (&Cl)[2], unsigned (&o)[2][2]) const {
#pragma unroll
        for (int h = 0; h < 2; ++h)
#pragma unroll
            for (int i = 0; i < 2; ++i) o[h][i] = (unsigned)rowmap[u.pm * 256 + h * 128 + Rl[i]] * 2048u + (unsigned)Cl[i] * 2u; }
};

__device__ __forceinline__ u32x4 pack8(const f32x4& v0, const f32x4& v1) { u32x4 w; w.x = cvt_pk_bf16(v0[0], v0[1]); w.y = cvt_pk_bf16(v0[2], v0[3]); w.z = cvt_pk_bf16(v1[0], v1[1]); w.w = cvt_pk_bf16(v1[2], v1[3]); return w; }

struct EpiInproj {
    static constexpr bool PERM = true;
    bf16* QKVG; bf16* ZT; bf16* ZTC; const float* rope;
    __device__ __forceinline__ void operator()(AccRef acc, const Unit& u, int wr, int wc, int fr, int fq) const {
        const int row0 = u.pm * 256 + wr * 64 + fr, col0 = u.pn * 256 + wc * 32 + 8 * fq;
        if (u.e == 0) {
            const int kind = u.pn >> 1; const bool lat = u.pm >= 16; const float sc = kind == 0 ? 0.125f : 1.0f; const bool dorope = (kind < 2) && lat;
#pragma unroll
            for (int ai = 0; ai < 2; ++ai)
#pragma unroll
                for (int m = 0; m < 4; ++m) {
                    const int row = row0 + ai * 128 + m * 16;
                    f32x4 cs0 = (f32x4){1.f, 0.f, 1.f, 0.f}, cs1 = cs0;
                    if (dorope) { const int t = (row - NCTX) & 4095; const int pos = (wc & 1) ? (t & 63) : (t >> 6); const f32x4* rp = (const f32x4*)(rope + pos * 32 + fq * 8); cs0 = rp[0]; cs1 = rp[1]; }
                    bf16* rowp = QKVG + (size_t)row * NQ + col0;
#pragma unroll
                    for (int bj = 0; bj < 2; ++bj) {
                        f32x4 v0 = acc[ai][bj][m][0] * sc, v1 = acc[ai][bj][m][1] * sc;
                        if (dorope) {
                            f32x4 r0, r1;
                            r0[0] = v0[0] * cs0[0] - v0[1] * cs0[1]; r0[1] = v0[0] * cs0[1] + v0[1] * cs0[0];
                            r0[2] = v0[2] * cs0[2] - v0[3] * cs0[3]; r0[3] = v0[2] * cs0[3] + v0[3] * cs0[2];
                            r1[0] = v1[0] * cs1[0] - v1[1] * cs1[1]; r1[1] = v1[0] * cs1[1] + v1[1] * cs1[0];
                            r1[2] = v1[2] * cs1[2] - v1[3] * cs1[3]; r1[3] = v1[2] * cs1[3] + v1[3] * cs1[2];
                            v0 = r0; v1 = r1; }
                        *(u32x4*)(rowp + bj * 128) = pack8(v0, v1); } }
        } else {
#pragma unroll
            for (int ai = 0; ai < 2; ++ai)
#pragma unroll
                for (int m = 0; m < 4; ++m) {
                    const int pj = row0 + ai * 128 + m * 16, part = pj >> 9, j = pj & 511;
#pragma unroll
                    for (int bj = 0; bj < 2; ++bj) {
                        const int cc = col0 + bj * 128; bf16* dst;
                        if (u.pn < 16) { const int b = u.pn, t = cc - 256 * b; dst = ZTC + ((size_t)(b * 512 + j) * 512 + part * 256 + t); }
                        else { const int tok = cc - NCTX, b = tok >> 12, t = tok & 4095; dst = ZT + ((size_t)(b * 512 + j) * 8192 + part * 4096 + t); }
                        *(u32x4*)dst = pack8(acc[ai][bj][m][0], acc[ai][bj][m][1]); } }
        }
    }
};
struct EpiCat {
    static constexpr bool PERM = true;
    bf16* CAT; int latent;
    __device__ __forceinline__ void operator()(AccRef acc, const Unit& u, int wr, int wc, int fr, int fq) const {
        const int rowbase = latent ? (NCTX + u.e * 4096) : (u.e * 256);
        const int row0 = rowbase + u.pm * 256 + wr * 64 + fr, col0 = u.pn * 256 + wc * 32 + 8 * fq;
#pragma unroll
        for (int ai = 0; ai < 2; ++ai)
#pragma unroll
            for (int m = 0; m < 4; ++m) { bf16* rowp = CAT + (size_t)(row0 + ai * 128 + m * 16) * 1024 + col0;
#pragma unroll
                for (int bj = 0; bj < 2; ++bj) *(u32x4*)(rowp + bj * 128) = pack8(acc[ai][bj][m][0], acc[ai][bj][m][1]); }
    }
};
struct EpiRes {
    static constexpr bool PERM = false;
    const float* xsrc; const float* csrc; float* xdst; float* cdst; const float* modv;
    __device__ __forceinline__ void operator()(AccRef acc, const Unit& u, int wr, int wc, int fr, int fq) const {
        const int row0 = u.pm * 256 + wr * 64 + fr, col0 = u.pn * 256 + wc * 32 + 4 * fq;
        const bool isctx = u.pm < 16; const int b = isctx ? 16 : ((u.pm - 16) >> 4);
        const float* src = isctx ? csrc : xsrc - (size_t)NCTX * 1024; float* dst = isctx ? cdst : xdst - (size_t)NCTX * 1024;
        f32x4 gv[2][2];
#pragma unroll
        for (int bj = 0; bj < 2; ++bj)
#pragma unroll
            for (int n = 0; n < 2; ++n) gv[bj][n] = *(const f32x4*)(modv + b * 6144 + 2048 + col0 + bj * 128 + n * 16);
#pragma unroll
        for (int ai = 0; ai < 2; ++ai)
#pragma unroll
            for (int m = 0; m < 4; ++m) { const size_t off = (size_t)(row0 + ai * 128 + m * 16) * 1024 + col0;
#pragma unroll
                for (int bj = 0; bj < 2; ++bj)
#pragma unroll
                    for (int n = 0; n < 2; ++n) { const f32x4 xv = *(const f32x4*)(src + off + bj * 128 + n * 16); *(f32x4*)(dst + off + bj * 128 + n * 16) = xv + gv[bj][n] * acc[ai][bj][m][n]; }
                asm volatile("" ::: "memory"); }
    }
};
struct EpiW1 {
    static constexpr bool PERM = true;
    bf16* ACT; const float* b1;
    __device__ __forceinline__ void operator()(AccRef acc, const Unit& u, int wr, int wc, int fr, int fq) const {
        const int row0 = u.pm * 256 + wr * 64 + fr, a0 = u.pn * 128 + wc * 32 + 8 * fq;
        const f32x4* bp = (const f32x4*)(b1 + u.e * 2048 + 2 * a0);
        const f32x4 q0 = bp[0], q1 = bp[1], q2 = bp[2], q3 = bp[3];
        const f32x4 bg0 = (f32x4){q0[0], q0[2], q1[0], q1[2]}, bl0 = (f32x4){q0[1], q0[3], q1[1], q1[3]};
        const f32x4 bg1 = (f32x4){q2[0], q2[2], q3[0], q3[2]}, bl1 = (f32x4){q2[1], q2[3], q3[1], q3[3]};
#pragma unroll
        for (int ai = 0; ai < 2; ++ai)
#pragma unroll
            for (int m = 0; m < 4; ++m) {
                f32x4 o[2];
#pragma unroll
                for (int n = 0; n < 2; ++n) {
                    const f32x4 g = acc[ai][0][m][n] + (n ? bg1 : bg0), lv = acc[ai][1][m][n] + (n ? bl1 : bl0);
#pragma unroll
                    for (int j = 0; j < 4; ++j) { const float xg = fminf(g[j], 7.0f), xl = fminf(fmaxf(lv[j], -7.0f), 7.0f);
                        const float sg = __builtin_amdgcn_rcpf(1.0f + __builtin_amdgcn_exp2f(-1.702f * 1.4426950408889634f * xg)); o[n][j] = xg * sg * (xl + 1.0f); } }
                *(u32x4*)(ACT + (size_t)(row0 + ai * 128 + m * 16) * 1024 + a0) = pack8(o[0], o[1]); }
    }
};
struct EpiW2 {
    static constexpr bool PERM = true;
    bf16* EOUT; const float* b2;
    __device__ __forceinline__ void operator()(AccRef acc, const Unit& u, int wr, int wc, int fr, int fq) const {
        const int row0 = u.pm * 256 + wr * 64 + fr, col0 = u.pn * 256 + wc * 32 + 8 * fq;
        f32x4 bv[2][2];
#pragma unroll
        for (int bj = 0; bj < 2; ++bj)
#pragma unroll
            for (int n = 0; n < 2; ++n) bv[bj][n] = *(const f32x4*)(b2 + u.e * 1024 + col0 + bj * 128 + 4 * n);
#pragma unroll
        for (int ai = 0; ai < 2; ++ai)
#pragma unroll
            for (int m = 0; m < 4; ++m) { bf16* rowp = EOUT + (size_t)(row0 + ai * 128 + m * 16) * 1024 + col0;
#pragma unroll
                for (int bj = 0; bj < 2; ++bj) *(u32x4*)(rowp + bj * 128) = pack8(acc[ai][bj][m][0] + bv[bj][0], acc[ai][bj][m][1] + bv[bj][1]); }
    }
};

template <int KIND>
__device__ __forceinline__ void transpose_item(const float* src, int ld, int k0, int c0, bf16* dst, int Kdst, int drow0, LAS float* scr, int lane) {
#pragma unroll 8
    for (int kk = 0; kk < 64; ++kk) scr[kk * 65 + lane] = src[(size_t)(k0 + kk) * ld + c0 + lane];
    LDS_WAIT();
    const int c = lane & 7;
#pragma unroll
    for (int j = 0; j < 8; ++j) { const int n = (lane >> 3) + 8 * j; const LAS float* s = scr + (8 * c) * 65 + n;
        u32x4 o; o.x = cvt_pk_bf16(s[0 * 65], s[1 * 65]); o.y = cvt_pk_bf16(s[2 * 65], s[3 * 65]); o.z = cvt_pk_bf16(s[4 * 65], s[5 * 65]); o.w = cvt_pk_bf16(s[6 * 65], s[7 * 65]);
        int row;
        if (KIND == 0) row = drow0 + n;
        else if (KIND == 1) row = drow0 + (n < 32 ? 2 * n : 2 * (n - 32) + 1);
        else { const int cs = c0 + n, a = cs >> 1; row = 256 * (a >> 7) + 128 * (cs & 1) + (a & 127); }
        *(u32x4*)(dst + (size_t)row * Kdst + k0 + 8 * c) = o; }
    LDS_WAIT();
}

__device__ __forceinline__ void p0_prologue(Frame& F, const Args& a) {
    const int gw = F.c * 8 + F.wave, NGW = F.G * 8, lane = F.lane;
    { LAS float* siluT = (LAS float*)F.lds;
      for (int i = F.tid; i < 17 * 1024; i += 512) { const int r = i >> 10, k = i & 1023; const float v = r < 16 ? a.in[I_C][r * 1024 + k] : a.in[I_CCTX][k]; siluT[i] = v / (1.0f + __expf(-v)); }
      __syncthreads();
      float* modp = (float*)(F.ws + WS_MODP);
      for (int it = gw; it < 192 * 8; it += NGW) {
          const int cg = it % 192, ks = it / 192, col = cg * 64 + lane, l = col / 6144, cc = col - l * 6144;
          const float* wp = a.in[I_MODW] + ((size_t)l * 1024 + ks * 128) * 6144 + cc;
          float acc[17];
#pragma unroll
          for (int r = 0; r < 17; ++r) acc[r] = 0.f;
#pragma unroll 4
          for (int k = 0; k < 128; ++k) { const float w = wp[(size_t)k * 6144];
#pragma unroll
              for (int r = 0; r < 17; ++r) acc[r] += siluT[r * 1024 + ks * 128 + k] * w; }
#pragma unroll
          for (int r = 0; r < 17; ++r) modp[(size_t)(ks * 17 + r) * 12288 + col] = acc[r];
      }
      __syncthreads(); }
    { LAS f32x2* tab = (LAS f32x2*)F.lds;
      for (int i = F.tid; i < 4096; i += 512) { float s, c; sincospif((float)i * (1.0f / 2048.0f), &s, &c); tab[i] = (f32x2){c, s}; }
      __syncthreads();
      bf16* dft = (bf16*)(F.ws + WS_DFT); bf16* dftc = (bf16*)(F.ws + WS_DFTC);
      for (int it = gw; it < 4096 + 256; it += NGW) {
          if (it < 4096) { const int tp = it;
              for (int cch = 0; cch < 16; ++cch) { const int k8 = (cch * 64 + lane) * 8; float v[8];
#pragma unroll
                  for (int e = 0; e < 8; ++e) { const int kk = k8 + e, part = kk >> 12, t = kk & 4095; const f32x2 cs = tab[(t * tp) & 4095]; v[e] = (part ? -cs.y : cs.x) * (1.0f / 64.0f); }
                  u32x4 o; o.x = cvt_pk_bf16(v[0], v[1]); o.y = cvt_pk_bf16(v[2], v[3]); o.z = cvt_pk_bf16(v[4], v[5]); o.w = cvt_pk_bf16(v[6], v[7]);
                  *(u32x4*)(dft + (size_t)tp * 8192 + k8) = o; } }
          else { const int tp = it - 4096, k8 = lane * 8; float v[8];
#pragma unroll
              for (int e = 0; e < 8; ++e) { const int kk = k8 + e, part = kk >> 8, t = kk & 255; const f32x2 cs = tab[((t * tp) & 255) * 16]; v[e] = (part ? -cs.y : cs.x) * (1.0f / 16.0f); }
              u32x4 o; o.x = cvt_pk_bf16(v[0], v[1]); o.y = cvt_pk_bf16(v[2], v[3]); o.z = cvt_pk_bf16(v[4], v[5]); o.w = cvt_pk_bf16(v[6], v[7]);
              *(u32x4*)(dftc + (size_t)tp * 512 + k8) = o; } }
      bf16* wf = (bf16*)(F.ws + WS_WF);
      for (int it = gw; it < 2 * 8 * 128; it += NGW) {
          const int l = it >> 10, g = (it >> 7) & 7, k8 = it & 127;
          float xin[8], ac[8], as[8];
#pragma unroll
          for (int kk = 0; kk < 8; ++kk) { xin[kk] = a.in[I_WIN][((size_t)l * 1024 + k8 * 8 + kk) * 2560 + g * 64 + lane]; ac[kk] = 0.f; as[kk] = 0.f; }
          for (int cidx = 0; cidx < 64; ++cidx) { const f32x2 cs = tab[((cidx * lane) & 63) * 64];
#pragma unroll
              for (int kk = 0; kk < 8; ++kk) { const float v = __shfl(xin[kk], cidx); ac[kk] += v * cs.x; as[kk] += v * cs.y; } }
          u32x4 oc, os;
          oc.x = cvt_pk_bf16(ac[0] * 0.125f, ac[1] * 0.125f); oc.y = cvt_pk_bf16(ac[2] * 0.125f, ac[3] * 0.125f); oc.z = cvt_pk_bf16(ac[4] * 0.125f, ac[5] * 0.125f); oc.w = cvt_pk_bf16(ac[6] * 0.125f, ac[7] * 0.125f);
          os.x = cvt_pk_bf16(as[0] * 0.125f, as[1] * 0.125f); os.y = cvt_pk_bf16(as[2] * 0.125f, as[3] * 0.125f); os.z = cvt_pk_bf16(as[4] * 0.125f, as[5] * 0.125f); os.w = cvt_pk_bf16(as[6] * 0.125f, as[7] * 0.125f);
          *(u32x4*)(wf + ((size_t)l * 1024 + g * 64 + lane) * 1024 + k8 * 8) = oc;
          *(u32x4*)(wf + ((size_t)l * 1024 + 512 + g * 64 + lane) * 1024 + k8 * 8) = os; }
      if (F.c == 0) { float* rope = (float*)(F.ws + WS_ROPE);
          for (int i = F.tid; i < 64 * 16; i += 512) { const int pos = i >> 4, f = i & 15; const float fr = powf(10000.0f, -(float)f / 16.0f); const float ang = (float)pos * fr; rope[i * 2] = cosf(ang); rope[i * 2 + 1] = sinf(ang); } }
      __syncthreads(); }
    { LAS float* scr = (LAS float*)(F.lds + F.wave * 16640);
      constexpr int N_IN = 2 * 16 * 32, N_OUT = 2 * 16 * 16, N_W1 = 64 * 16 * 32, N_W2 = 64 * 16 * 16, NITEMS = N_IN + N_OUT + N_W1 + N_W2;
      for (int it = gw; it < NITEMS; it += NGW) {
          int r = it;
          if (r < N_W1) { const int le = r >> 9, kb = (r >> 5) & 15, nb = r & 31;
              transpose_item<2>(a.in[I_W1] + (size_t)le * 1024 * 2048, 2048, kb * 64, nb * 64, (bf16*)(F.ws + WS_W1) + (size_t)le * 2048 * 1024, 1024, 0, scr, lane); continue; }
          r -= N_W1;
          if (r < N_W2) { const int le = r >> 8, kb = (r >> 4) & 15, nb = r & 15;
              transpose_item<0>(a.in[I_W2] + (size_t)le * 1024 * 1024, 1024, kb * 64, nb * 64, (bf16*)(F.ws + WS_W2) + (size_t)le * 1024 * 1024, 1024, nb * 64, scr, lane); continue; }
          r -= N_W2;
          if (r < N_IN) { const int l = r >> 9, kb = (r >> 5) & 15, nb = r & 31; const float* src = a.in[I_WIN] + (size_t)l * 1024 * 2560; bf16* dst = (bf16*)(F.ws + WS_WQ) + (size_t)l * 2048 * 1024;
              if (nb < 16) transpose_item<1>(src, 2560, kb * 64, 512 + nb * 64, dst, 1024, nb * 64, scr, lane);
              else transpose_item<0>(src, 2560, kb * 64, 512 + nb * 64, dst, 1024, nb * 64, scr, lane);
              continue; }
          r -= N_IN;
          { const int l = r >> 8, kb = (r >> 4) & 15, nb = r & 15;
            transpose_item<0>(a.in[I_WOUT] + (size_t)l * 1024 * 1024, 1024, kb * 64, nb * 64, (bf16*)(F.ws + WS_WO) + (size_t)l * 1024 * 1024, 1024, nb * 64, scr, lane); }
      } }
}

__device__ __forceinline__ float mod_sum(const float* modp, const float* modb, int l, int r, int cc) {
    float s = modb[l * 6144 + cc];
#pragma unroll
    for (int ks = 0; ks < 8; ++ks) s += modp[(size_t)(ks * 17 + r) * 12288 + l * 6144 + cc];
    return s;
}
__device__ __forceinline__ void p0b_finalize(Frame& F, const Args& a) {
    const float* modp = (const float*)(F.ws + WS_MODP); float* modv = (float*)(F.ws + WS_MODV); float* a12 = (float*)(F.ws + WS_A12);
    const int gt = F.c * 512 + F.tid, NT = F.G * 512;
    for (int i = gt; i < 2 * 17 * 6144; i += NT) { const int l = i / (17 * 6144), rem = i - l * 17 * 6144, r = rem / 6144, cc = rem - r * 6144; modv[i] = mod_sum(modp, a.in[I_MODB], l, r, cc); }
    for (int i = gt; i < 2 * 2 * 17 * 1024; i += NT) { const int k = i & 1023, r = (i >> 10) % 17, w = ((i >> 10) / 17) & 1, l = (i >> 10) / 34;
        a12[i] = a.in[I_NORMW][(l * 2 + w) * 1024 + k] * (1.0f + mod_sum(modp, a.in[I_MODB], l, r, (w ? 4096 : 1024) + k)); }
}

__device__ __forceinline__ void norm_row(const float* xrow, const float* gain, const float* shift, bf16* orow, int lane) {
    f32x4 v[4]; float ss = 0.f;
#pragma unroll
    for (int j = 0; j < 4; ++j) { v[j] = ((const f32x4*)xrow)[lane + 64 * j]; ss += (v[j][0] * v[j][0] + v[j][1] * v[j][1]) + (v[j][2] * v[j][2] + v[j][3] * v[j][3]); }
    const float r = rsqrtf(wave_sum(ss) * (1.0f / 1024.0f) + NORM_EPS);
#pragma unroll
    for (int j = 0; j < 4; ++j) { const f32x4 g = ((const f32x4*)gain)[lane + 64 * j], s = ((const f32x4*)shift)[lane + 64 * j]; const f32x4 h = v[j] * r * g + s;
        u32x2 w; w.x = cvt_pk_bf16(h[0], h[1]); w.y = cvt_pk_bf16(h[2], h[3]); ((u32x2*)orow)[lane + 64 * j] = w; }
}
__device__ __forceinline__ void p1_norm1_layer0(Frame& F, const Args& a) {
    const int gw = F.c * 8 + F.wave, NGW = F.G * 8;
    const float* a12 = (const float*)(F.ws + WS_A12); const float* modv = (const float*)(F.ws + WS_MODV); bf16* H = (bf16*)(F.ws + WS_H);
    for (int r = gw; r < MT; r += NGW) { const int b = batch_of_row(r);
        const float* xrow = r < NCTX ? a.in[I_CTX] + (size_t)r * 1024 : a.in[I_X] + (size_t)(r - NCTX) * 1024;
        norm_row(xrow, a12 + (size_t)(0 * 17 + b) * 1024, modv + (size_t)b * 6144 + 0, H + (size_t)r * 1024, F.lane); }
}

__device__ __forceinline__ void retention_phase(Frame& F, const Args& a, int l) {
    constexpr int QS = 72, TS = 136, SS = 72;
    constexpr int O_Q = 0, O_K = 18432, O_V = 36864, O_KT = 55296, O_VT = 72704, O_P = 90112, O_ST = 124928;
    LAS bf16* Qs = (LAS bf16*)(F.lds + O_Q); LAS bf16* Ks = (LAS bf16*)(F.lds + O_K); LAS bf16* Vs = (LAS bf16*)(F.lds + O_V);
    LAS bf16* KT = (LAS bf16*)(F.lds + O_KT); LAS bf16* VT = (LAS bf16*)(F.lds + O_VT); LAS bf16* Ps = (LAS bf16*)(F.lds + O_P); LAS bf16* ST = (LAS bf16*)(F.lds + O_ST);
    const bf16* QKVG = (const bf16*)(F.ws + WS_QKVG);
    const int tid = F.tid, lane = F.lane, w = F.wave, lr = lane & 15, lq = lane >> 4;
    for (int unit = F.c; unit < 256; unit += F.G) {
        const int dir = unit & 1, h = (unit >> 1) & 7, b = unit >> 4;
        bf16* OUT = (bf16*)(F.ws + (dir ? WS_OB : WS_OF));
        const float rd = a.in[I_DECAY][l * 16 + dir * 8 + h];
        const float lg2 = log1pf(-exp2f(-rd)) * 1.4426950408889634f;
        const int il = 16 * w + lr;
        float mask[8][4];
#pragma unroll
        for (int jt = 0; jt < 8; ++jt)
#pragma unroll
            for (int r = 0; r < 4; ++r) { const int j = 16 * jt + 4 * lq + r; mask[jt][r] = (j <= il) ? exp2f((float)(il - j) * lg2) : 0.0f; }
        const float wq = exp2f((float)(il + 1) * lg2), gch = exp2f(128.0f * lg2);
        const int ldr = tid >> 2, ldq = tid & 3;
        const int trr = tid & 127, trq = tid >> 7;
        const float wkv = exp2f((float)(127 - trr) * lg2);
        f32x4 Sacc[2] = {(f32x4){0.f, 0.f, 0.f, 0.f}, (f32x4){0.f, 0.f, 0.f, 0.f}};
        const int tm = w >> 1, tn0 = 2 * (w & 1);
        for (int i = tid; i < 64 * SS / 2; i += 512) ((LAS unsigned*)ST)[i] = 0u;
        u32x4 pq[2], pk[2], pv[2];
        auto chunk_base = [&](int s) -> int { if (s < 2) return b * 256 + 128 * (dir ? 1 - s : s); return NCTX + b * 4096 + 128 * (dir ? 31 - (s - 2) : (s - 2)); };
        { const int gr = chunk_base(0) + (dir ? 127 - ldr : ldr); const bf16* p = QKVG + (size_t)gr * NQ + h * 64 + ldq * 16;
          pq[0] = *(const u32x4*)p; pq[1] = *(const u32x4*)(p + 8); pk[0] = *(const u32x4*)(p + 512); pk[1] = *(const u32x4*)(p + 520); pv[0] = *(const u32x4*)(p + 1024); pv[1] = *(const u32x4*)(p + 1032); }
        for (int s = 0; s < 34; ++s) {
            const int cb = chunk_base(s);
            { const int o = ldr * QS + ldq * 16;
              *(LAS u32x4*)(Qs + o) = pq[0]; *(LAS u32x4*)(Qs + o + 8) = pq[1]; *(LAS u32x4*)(Ks + o) = pk[0]; *(LAS u32x4*)(Ks + o + 8) = pk[1]; *(LAS u32x4*)(Vs + o) = pv[0]; *(LAS u32x4*)(Vs + o + 8) = pv[1]; }
            __syncthreads();
            if (s + 1 < 34) { const int gr = chunk_base(s + 1) + (dir ? 127 - ldr : ldr); const bf16* p = QKVG + (size_t)gr * NQ + h * 64 + ldq * 16;
                pq[0] = *(const u32x4*)p; pq[1] = *(const u32x4*)(p + 8); pk[0] = *(const u32x4*)(p + 512); pk[1] = *(const u32x4*)(p + 520); pv[0] = *(const u32x4*)(p + 1024); pv[1] = *(const u32x4*)(p + 1032); }
            { const u32x4 k0 = *(const LAS u32x4*)(Ks + trr * QS + trq * 16), k1 = *(const LAS u32x4*)(Ks + trr * QS + trq * 16 + 8);
              const u32x4 v0 = *(const LAS u32x4*)(Vs + trr * QS + trq * 16), v1 = *(const LAS u32x4*)(Vs + trr * QS + trq * 16 + 8);
              const unsigned kw[8] = {k0.x, k0.y, k0.z, k0.w, k1.x, k1.y, k1.z, k1.w}, vw[8] = {v0.x, v0.y, v0.z, v0.w, v1.x, v1.y, v1.z, v1.w};
#pragma unroll
              for (int e = 0; e < 8; ++e) { const unsigned kk = cvt_pk_bf16(bf_lo(kw[e]) * wkv, bf_hi(kw[e]) * wkv);
                  KT[(trq * 16 + 2 * e) * TS + trr] = (bf16)(kk & 0xffffu); KT[(trq * 16 + 2 * e + 1) * TS + trr] = (bf16)(kk >> 16);
                  VT[(trq * 16 + 2 * e) * TS + trr] = (bf16)(vw[e] & 0xffffu); VT[(trq * 16 + 2 * e + 1) * TS + trr] = (bf16)(vw[e] >> 16); } }
            __syncthreads();
            bf16x8 bq[2];
#pragma unroll
            for (int ks = 0; ks < 2; ++ks) bq[ks] = *(const LAS bf16x8*)(Qs + (16 * w + lr) * QS + 32 * ks + 8 * lq);
#pragma unroll
            for (int jt = 0; jt < 8; ++jt) {
                f32x4 p = (f32x4){0.f, 0.f, 0.f, 0.f};
#pragma unroll
                for (int ks = 0; ks < 2; ++ks) { const bf16x8 ak = *(const LAS bf16x8*)(Ks + (16 * jt + lr) * QS + 32 * ks + 8 * lq); p = __builtin_amdgcn_mfma_f32_16x16x32_bf16(ak, bq[ks], p, 0, 0, 0); }
                u32x2 pw; pw.x = cvt_pk_bf16(p[0] * mask[jt][0], p[1] * mask[jt][1]); pw.y = cvt_pk_bf16(p[2] * mask[jt][2], p[3] * mask[jt][3]);
                *(LAS u32x2*)(Ps + (16 * w + lr) * TS + 16 * jt + 4 * lq) = pw; }
            LDS_WAIT();
            f32x4 oacc[4], cacc[4];
#pragma unroll
            for (int tn = 0; tn < 4; ++tn) { oacc[tn] = (f32x4){0.f, 0.f, 0.f, 0.f}; cacc[tn] = (f32x4){0.f, 0.f, 0.f, 0.f}; }
#pragma unroll
            for (int ks = 0; ks < 4; ++ks) { const bf16x8 bp = *(const LAS bf16x8*)(Ps + (16 * w + lr) * TS + 32 * ks + 8 * lq);
#pragma unroll
                for (int tn = 0; tn < 4; ++tn) { const bf16x8 av = *(const LAS bf16x8*)(VT + (16 * tn + lr) * TS + 32 * ks + 8 * lq); oacc[tn] = __builtin_amdgcn_mfma_f32_16x16x32_bf16(av, bp, oacc[tn], 0, 0, 0); } }
#pragma unroll
            for (int ks = 0; ks < 2; ++ks)
#pragma unroll
                for (int tn = 0; tn < 4; ++tn) { const bf16x8 as_ = *(const LAS bf16x8*)(ST + (16 * tn + lr) * SS + 32 * ks + 8 * lq); cacc[tn] = __builtin_amdgcn_mfma_f32_16x16x32_bf16(as_, bq[ks], cacc[tn], 0, 0, 0); }
            { const int gr = cb + (dir ? 127 - il : il); bf16* op = OUT + (size_t)gr * 512 + h * 64 + 4 * lq;
#pragma unroll
              for (int tn = 0; tn < 4; ++tn) { const f32x4 o = oacc[tn] + cacc[tn] * wq; u32x2 ow; ow.x = cvt_pk_bf16(o[0], o[1]); ow.y = cvt_pk_bf16(o[2], o[3]); *(u32x2*)(op + 16 * tn) = ow; } }
            f32x4 sn[2] = {(f32x4){0.f, 0.f, 0.f, 0.f}, (f32x4){0.f, 0.f, 0.f, 0.f}};
#pragma unroll
            for (int ks = 0; ks < 4; ++ks) { const bf16x8 ak = *(const LAS bf16x8*)(KT + (16 * tm + lr) * TS + 32 * ks + 8 * lq);
#pragma unroll
                for (int q = 0; q < 2; ++q) { const bf16x8 bv = *(const LAS bf16x8*)(VT + (16 * (tn0 + q) + lr) * TS + 32 * ks + 8 * lq); sn[q] = __builtin_amdgcn_mfma_f32_16x16x32_bf16(ak, bv, sn[q], 0, 0, 0); } }
#pragma unroll
            for (int q = 0; q < 2; ++q) Sacc[q] = Sacc[q] * gch + sn[q];
            __syncthreads();
#pragma unroll
            for (int q = 0; q < 2; ++q) { u32x2 sw; sw.x = cvt_pk_bf16(Sacc[q][0], Sacc[q][1]); sw.y = cvt_pk_bf16(Sacc[q][2], Sacc[q][3]); *(LAS u32x2*)(ST + (16 * (tn0 + q) + lr) * SS + 16 * tm + 4 * lq) = sw; }
        }
        __syncthreads();
    }
}

__device__ __forceinline__ void merge_phase(Frame& F, const Args& a, int l) {
    const int gw = F.c * 8 + F.wave, NGW = F.G * 8, lane = F.lane;
    const bf16* OFp = (const bf16*)(F.ws + WS_OF); const bf16* OBp = (const bf16*)(F.ws + WS_OB); const bf16* QKVG = (const bf16*)(F.ws + WS_QKVG); bf16* CAT = (bf16*)(F.ws + WS_CAT);
    const float* rw = a.in[I_RNW] + l * 512 + lane * 8;
    const f32x4 w0 = *(const f32x4*)rw, w1 = *(const f32x4*)(rw + 4);
    for (int r = gw + (l ? NCTX : 0); r < MT; r += NGW) {
        const u32x4 f = *(const u32x4*)(OFp + (size_t)r * 512 + lane * 8), bk = *(const u32x4*)(OBp + (size_t)r * 512 + lane * 8), g = *(const u32x4*)(QKVG + (size_t)r * NQ + 1536 + lane * 8);
        float o[8]; const unsigned fw[4] = {f.x, f.y, f.z, f.w}, bw[4] = {bk.x, bk.y, bk.z, bk.w}, gwd[4] = {g.x, g.y, g.z, g.w};
        float s = 0.f;
#pragma unroll
        for (int e = 0; e < 4; ++e) { o[2 * e] = bf_lo(fw[e]) + bf_lo(bw[e]); o[2 * e + 1] = bf_hi(fw[e]) + bf_hi(bw[e]); s += o[2 * e] + o[2 * e + 1]; }
        s += __shfl_xor(s, 1); s += __shfl_xor(s, 2); s += __shfl_xor(s, 4);
        const float mu = s * (1.0f / 64.0f); float q = 0.f;
#pragma unroll
        for (int e = 0; e < 8; ++e) { o[e] -= mu; q += o[e] * o[e]; }
        q += __shfl_xor(q, 1); q += __shfl_xor(q, 2); q += __shfl_xor(q, 4);
        const float rs = rsqrtf(q * (1.0f / 64.0f) + NORM_EPS);
        float y[8];
#pragma unroll
        for (int e = 0; e < 4; ++e) { const float g0 = bf_lo(gwd[e]), g1 = bf_hi(gwd[e]);
            y[2 * e] = g0 / (1.0f + __expf(-g0)) * o[2 * e] * rs; y[2 * e + 1] = g1 / (1.0f + __expf(-g1)) * o[2 * e + 1] * rs; }
        u32x4 ow; ow.x = cvt_pk_bf16(y[0] * w0[0], y[1] * w0[1]); ow.y = cvt_pk_bf16(y[2] * w0[2], y[3] * w0[3]); ow.z = cvt_pk_bf16(y[4] * w1[0], y[5] * w1[1]); ow.w = cvt_pk_bf16(y[6] * w1[2], y[7] * w1[3]);
        *(u32x4*)(CAT + (size_t)r * 1024 + 512 + lane * 8) = ow;
    }
}

__device__ __forceinline__ void router_phase(Frame& F, const Args& a, int l) {
    LAS unsigned char* wt = F.lds; LAS float* scr = (LAS float*)(F.lds + 131072 + F.wave * 2112); LAS unsigned* hist = (LAS unsigned*)(F.lds + 131072 + 16896);
    const int tid = F.tid, lane = F.lane, lr = lane & 15, lq = lane >> 4;
    const float* rwp = a.in[I_RW] + (size_t)l * 1024 * 32;
    for (int i = tid; i < 32 * 2 * 64; i += 512) { const int ln = i & 63, et = (i >> 6) & 1, ks = i >> 7; float hi[8], lo[8];
#pragma unroll
        for (int e = 0; e < 8; ++e) { const float wv = rwp[(size_t)(32 * ks + 8 * (ln >> 4) + e) * 32 + 16 * et + (ln & 15)]; const unsigned hb = cvt_pk_bf16(wv, 0.f) & 0xffffu; hi[e] = __uint_as_float(hb << 16); lo[e] = wv - hi[e]; }
        u32x4 wh, wl; wh.x = cvt_pk_bf16(hi[0], hi[1]); wh.y = cvt_pk_bf16(hi[2], hi[3]); wh.z = cvt_pk_bf16(hi[4], hi[5]); wh.w = cvt_pk_bf16(hi[6], hi[7]);
        wl.x = cvt_pk_bf16(lo[0], lo[1]); wl.y = cvt_pk_bf16(lo[2], lo[3]); wl.z = cvt_pk_bf16(lo[4], lo[5]); wl.w = cvt_pk_bf16(lo[6], lo[7]);
        *(LAS u32x4*)(wt + ((ks * 2 + et) * 2 + 0) * 1024 + ln * 16) = wh; *(LAS u32x4*)(wt + ((ks * 2 + et) * 2 + 1) * 1024 + ln * 16) = wl; }
    if (tid < 32) hist[tid] = 0u;
    __syncthreads();
    const int row_start = l ? NCTX : 0, ntask = (MT - row_start) / 16;
    const float* a12 = (const float*)(F.ws + WS_A12) + (size_t)(l * 2 + 1) * 17 * 1024; const float* modv = (const float*)(F.ws + WS_MODV) + (size_t)l * 17 * 6144;
    bf16* H = (bf16*)(F.ws + WS_H); int* tope = (int*)(F.ws + WS_TOPE); float* topg = (float*)(F.ws + WS_TOPG);
    const float* xlat = a.out; const float* xctx = (const float*)(F.ws + WS_XCTX);
    for (int task = F.c * 8 + F.wave; task < ntask; task += F.G * 8) {
        const int R0 = row_start + task * 16, row = R0 + lr, b = batch_of_row(R0);
        const float* xrow = (row < NCTX ? xctx + (size_t)row * 1024 : xlat + (size_t)(row - NCTX) * 1024) + 8 * lq;
        const float* gp = a12 + (size_t)b * 1024 + 8 * lq; const float* sp = modv + (size_t)b * 6144 + 3072 + 8 * lq;
        float ss = 0.f;
#pragma unroll 8
        for (int ks = 0; ks < 32; ++ks) { const f32x4 x0 = *(const f32x4*)(xrow + 32 * ks), x1 = *(const f32x4*)(xrow + 32 * ks + 4);
            ss += (x0[0] * x0[0] + x0[1] * x0[1]) + (x0[2] * x0[2] + x0[3] * x0[3]) + (x1[0] * x1[0] + x1[1] * x1[1]) + (x1[2] * x1[2] + x1[3] * x1[3]); }
        ss += __shfl_xor(ss, 16); ss += __shfl_xor(ss, 32);
        const float rn = rsqrtf(ss * (1.0f / 1024.0f) + NORM_EPS);
        f32x4 acc0 = (f32x4){0.f, 0.f, 0.f, 0.f}, acc1 = acc0;
        bf16* hrow = H + (size_t)row * 1024 + 8 * lq;
#pragma unroll 2
        for (int ks = 0; ks < 32; ++ks) {
            const f32x4 x0 = *(const f32x4*)(xrow + 32 * ks), x1 = *(const f32x4*)(xrow + 32 * ks + 4);
            const f32x4 g0 = *(const f32x4*)(gp + 32 * ks), g1 = *(const f32x4*)(gp + 32 * ks + 4), s0 = *(const f32x4*)(sp + 32 * ks), s1 = *(const f32x4*)(sp + 32 * ks + 4);
            const f32x4 h0 = x0 * rn * g0 + s0, h1 = x1 * rn * g1 + s1;
            const u32x4 hw = pack8(h0, h1);
            *(u32x4*)(hrow + 32 * ks) = hw;
            f32x4 l0, l1; l0[0] = h0[0] - bf_lo(hw.x); l0[1] = h0[1] - bf_hi(hw.x); l0[2] = h0[2] - bf_lo(hw.y); l0[3] = h0[3] - bf_hi(hw.y);
            l1[0] = h1[0] - bf_lo(hw.z); l1[1] = h1[1] - bf_hi(hw.z); l1[2] = h1[2] - bf_lo(hw.w); l1[3] = h1[3] - bf_hi(hw.w);
            const u32x4 lw = pack8(l0, l1);
            const bf16x8 ahi = __builtin_bit_cast(bf16x8, hw), alo = __builtin_bit_cast(bf16x8, lw);
            const bf16x8 b0h = *(const LAS bf16x8*)(wt + ((ks * 2 + 0) * 2 + 0) * 1024 + lane * 16), b0l = *(const LAS bf16x8*)(wt + ((ks * 2 + 0) * 2 + 1) * 1024 + lane * 16);
            const bf16x8 b1h = *(const LAS bf16x8*)(wt + ((ks * 2 + 1) * 2 + 0) * 1024 + lane * 16), b1l = *(const LAS bf16x8*)(wt + ((ks * 2 + 1) * 2 + 1) * 1024 + lane * 16);
            acc0 = __builtin_amdgcn_mfma_f32_16x16x32_bf16(ahi, b0h, acc0, 0, 0, 0); acc0 = __builtin_amdgcn_mfma_f32_16x16x32_bf16(ahi, b0l, acc0, 0, 0, 0); acc0 = __builtin_amdgcn_mfma_f32_16x16x32_bf16(alo, b0h, acc0, 0, 0, 0);
            acc1 = __builtin_amdgcn_mfma_f32_16x16x32_bf16(ahi, b1h, acc1, 0, 0, 0); acc1 = __builtin_amdgcn_mfma_f32_16x16x32_bf16(ahi, b1l, acc1, 0, 0, 0); acc1 = __builtin_amdgcn_mfma_f32_16x16x32_bf16(alo, b1h, acc1, 0, 0, 0);
        }
        const float rb0 = a.in[I_RB][l * 32 + lr], rb1 = a.in[I_RB][l * 32 + 16 + lr];
#pragma unroll
        for (int r = 0; r < 4; ++r) { scr[(4 * lq + r) * 33 + lr] = acc0[r] + rb0; scr[(4 * lq + r) * 33 + 16 + lr] = acc1[r] + rb1; }
        LDS_WAIT();
        if (lane < 16) {
            float v0 = -3.0e38f, v1 = -3.0e38f, v2 = -3.0e38f, v3 = -3.0e38f; int i0 = 0, i1 = 0, i2 = 0, i3 = 0;
#pragma unroll
            for (int e = 0; e < 32; ++e) { const float x = scr[lane * 33 + e];
                if (x > v3) {
                    if (x > v0) { v3 = v2; i3 = i2; v2 = v1; i2 = i1; v1 = v0; i1 = i0; v0 = x; i0 = e; }
                    else if (x > v1) { v3 = v2; i3 = i2; v2 = v1; i2 = i1; v1 = x; i1 = e; }
                    else if (x > v2) { v3 = v2; i3 = i2; v2 = x; i2 = e; }
                    else { v3 = x; i3 = e; } } }
            const float e1 = __expf(v1 - v0), e2 = __expf(v2 - v0), e3 = __expf(v3 - v0), inv = 1.0f / (1.0f + e1 + e2 + e3);
            const int rr = R0 + lane;
            *(int4*)(tope + (size_t)rr * 4) = make_int4(i0, i1, i2, i3);
            *(f32x4*)(topg + (size_t)rr * 4) = (f32x4){inv, e1 * inv, e2 * inv, e3 * inv};
            lds_add(&hist[i0], 1u); lds_add(&hist[i1], 1u); lds_add(&hist[i2], 1u); lds_add(&hist[i3], 1u);
        }
        LDS_WAIT();
    }
    __syncthreads();
    if (tid < 32) atomicAdd(F.ctl + CW_CNT + l * 64 + tid, hist[tid]);
}

__device__ __forceinline__ void dispatch_phase(Frame& F, int l) {
    LAS unsigned* L = (LAS unsigned*)F.lds;
    const int tid = F.tid;
    const int* tope = (const int*)(F.ws + WS_TOPE); int* dest = (int*)(F.ws + WS_DEST); int* rowmap = (int*)(F.ws + WS_ROWMAP); int* tile_e = (int*)(F.ws + WS_TILEE);
    if (tid < 32) { L[tid] = __hip_atomic_load(F.ctl + CW_CNT + l * 64 + tid, __ATOMIC_RELAXED, __HIP_MEMORY_SCOPE_AGENT); L[96 + tid] = 0u; L[128 + tid] = 0u; }
    __syncthreads();
    if (tid == 0) { unsigned off = 0; for (int e = 0; e < 32; ++e) { L[32 + e] = off; off += ((L[e] + 255u) >> 8) << 8; } L[64] = off; }
    __syncthreads();
    const int row_start = l ? NCTX : 0, nrows = MT - row_start, rpb = (nrows + F.G - 1) / F.G;
    const int r0 = row_start + F.c * rpb, r1 = (r0 + rpb < MT) ? r0 + rpb : MT, na = (r1 > r0 ? (r1 - r0) * 4 : 0);
    for (int i = tid; i < na; i += 512) lds_add(&L[96 + tope[(size_t)r0 * 4 + i]], 1u);
    __syncthreads();
    if (tid < 32) L[160 + tid] = atomicAdd(F.ctl + CW_CUR + l * 64 + tid, L[96 + tid]);
    __syncthreads();
    for (int i = tid; i < na; i += 512) { const int e = tope[(size_t)r0 * 4 + i]; const unsigned p = L[32 + e] + L[160 + e] + lds_add(&L[128 + e], 1u); rowmap[p] = r0 + (i >> 2); dest[(size_t)r0 * 4 + i] = (int)p; }
    if (F.c < 32) { const int e = F.c; const unsigned pe = L[32 + e] + L[e], pn = L[33 + e];
        for (unsigned p = pe + tid; p < pn; p += 512) rowmap[p] = row_start;
        for (unsigned t = (L[32 + e] >> 8) + tid; t < (pn >> 8); t += 512) tile_e[t] = e; }
    if (F.c == 0 && tid == 0) F.ctl[CW_NT + l * 64] = L[64] >> 8;
    __syncthreads();
}

__device__ __forceinline__ void combine_phase(Frame& F, const Args& a, int l) {
    const int gw = F.c * 8 + F.wave, NGW = F.G * 8, lane = F.lane;
    const bf16* EOUT = (const bf16*)(F.ws + WS_EOUT); const int* dest = (const int*)(F.ws + WS_DEST); const float* topg = (const float*)(F.ws + WS_TOPG);
    const float* modv = (const float*)(F.ws + WS_MODV) + (size_t)l * 17 * 6144; float* xctx = (float*)(F.ws + WS_XCTX); float* xlat = a.out; bf16* H = (bf16*)(F.ws + WS_H);
    const float* a12n = (const float*)(F.ws + WS_A12) + (size_t)(1 * 2 + 0) * 17 * 1024; const float* modvn = (const float*)(F.ws + WS_MODV) + (size_t)1 * 17 * 6144;
    for (int r = gw + (l ? NCTX : 0); r < MT; r += NGW) {
        const int b = batch_of_row(r);
        float* xrow = r < NCTX ? xctx + (size_t)r * 1024 : xlat + (size_t)(r - NCTX) * 1024;
        const int4 d = *(const int4*)(dest + (size_t)r * 4); const f32x4 g = *(const f32x4*)(topg + (size_t)r * 4);
        const int dd[4] = {d.x, d.y, d.z, d.w};
        f32x4 v[4]; float ss = 0.f;
#pragma unroll
        for (int j = 0; j < 4; ++j) {
            f32x4 s = (f32x4){0.f, 0.f, 0.f, 0.f};
#pragma unroll
            for (int k = 0; k < 4; ++k) { const u32x2 w = ((const u32x2*)(EOUT + (size_t)dd[k] * 1024))[lane + 64 * j]; s += (f32x4){bf_lo(w.x), bf_hi(w.x), bf_lo(w.y), bf_hi(w.y)} * g[k]; }
            const f32x4 mg = ((const f32x4*)(modv + (size_t)b * 6144 + 5120))[lane + 64 * j];
            v[j] = ((const f32x4*)xrow)[lane + 64 * j] + mg * s;
            ss += (v[j][0] * v[j][0] + v[j][1] * v[j][1]) + (v[j][2] * v[j][2] + v[j][3] * v[j][3]); }
        const float rn = rsqrtf(wave_sum(ss) * (1.0f / 1024.0f) + NORM_EPS);
        if (l == 0) {
            const float* gain = a12n + (size_t)b * 1024; const float* shift = modvn + (size_t)b * 6144;
#pragma unroll
            for (int j = 0; j < 4; ++j) { ((f32x4*)xrow)[lane + 64 * j] = v[j];
                const f32x4 gg = ((const f32x4*)gain)[lane + 64 * j], sh = ((const f32x4*)shift)[lane + 64 * j]; const f32x4 hh = v[j] * rn * gg + sh;
                u32x2 w; w.x = cvt_pk_bf16(hh[0], hh[1]); w.y = cvt_pk_bf16(hh[2], hh[3]); ((u32x2*)(H + (size_t)r * 1024))[lane + 64 * j] = w; }
        } else {
#pragma unroll
            for (int j = 0; j < 4; ++j) { const f32x4 fw = ((const f32x4*)a.in[I_FNW])[lane + 64 * j]; ((f32x4*)xrow)[lane + 64 * j] = v[j] * rn * fw; }
        }
    }
}

__global__ void __launch_bounds__(512, 2) fwd_kernel(Args args) {
    extern __shared__ __attribute__((aligned(16))) unsigned char lds_raw[];
    Frame F;
    F.lds = (LAS unsigned char*)lds_raw; F.ws = args.ws; F.ctl = (unsigned*)(args.ws + WS_CTL);
    F.tid = threadIdx.x; F.lane = F.tid & 63; F.wave = __builtin_amdgcn_readfirstlane(F.tid >> 6); F.G = gridDim.x; F.c = blockIdx.x;
    volatile LAS unsigned* misc = (volatile LAS unsigned*)(F.lds + LDS_MISC);
    if (F.tid < 64) misc[F.tid] = 0u;
    __syncthreads();
    XcdBarrier bar = xcd_barrier_post(F.ctl + CW_BAR, misc + 8);
#define GRID_BAR() xcd_barrier(bar)
#define FRESH() do { size_t z_ = 0; asm volatile("" : "+s"(z_)); F.ws = args.ws + z_; int t_ = threadIdx.x; asm volatile("" : "+v"(t_)); F.tid = t_; F.lane = t_ & 63; } while (0)

    FRESH(); if (PH(0)) p0_prologue(F, args);
    GRID_BAR();
    FRESH(); if (PH(1)) p0b_finalize(F, args);
    GRID_BAR();
    FRESH(); if (PH(1)) p1_norm1_layer0(F, args);
    GRID_BAR();

    for (int l = 0; l < 2; ++l) {
        FRESH(); if (PH(2)) { SchedInproj S{(const char*)(F.ws + WS_H), (const char*)(F.ws + WS_WQ) + (size_t)l * 2048 * 1024 * 2, (const char*)(F.ws + WS_WF) + (size_t)l * 1024 * 1024 * 2, F.G, F.c};
          EpiInproj E{(bf16*)(F.ws + WS_QKVG), (bf16*)(F.ws + WS_ZT), (bf16*)(F.ws + WS_ZTC), (const float*)(F.ws + WS_ROPE)};
          pg8::gemm_phase<EpiInproj, SchedInproj, false, true>(F.lds, 1024, S, E); }
        GRID_BAR();
        FRESH(); if (PH(3)) retention_phase(F, args, l);
        GRID_BAR();
        FRESH(); if (PH(4)) merge_phase(F, args, l);
        FRESH(); if (PH(5)) { SchedDft S{(const char*)(F.ws + WS_DFT), (const char*)(F.ws + WS_ZT), F.G, F.c}; EpiCat E{(bf16*)(F.ws + WS_CAT), 1};
          pg8::gemm_phase<EpiCat, SchedDft, false, true>(F.lds, 8192, S, E); }
        FRESH(); if (PH(5) && l == 0) { SchedDftC S{(const char*)(F.ws + WS_DFTC), (const char*)(F.ws + WS_ZTC), F.G, F.c}; EpiCat E{(bf16*)(F.ws + WS_CAT), 0};
          pg8::gemm_phase<EpiCat, SchedDftC, false, true>(F.lds, 512, S, E); }
        GRID_BAR();
        FRESH(); if (PH(6)) { SchedReg S{(const char*)(F.ws + WS_CAT), (const char*)(F.ws + WS_WO) + (size_t)l * 1024 * 1024 * 2, l ? 256 : 272, 4, l ? 16 : 0, F.G, F.c, (size_t)256 * 1024 * 2};
          EpiRes E{l ? args.out : args.in[I_X], l ? (const float*)(F.ws + WS_XCTX) : args.in[I_CTX], args.out, (float*)(F.ws + WS_XCTX), (const float*)(F.ws + WS_MODV) + (size_t)l * 17 * 6144};
          pg8::gemm_phase<EpiRes, SchedReg, false, true>(F.lds, 1024, S, E); }
        GRID_BAR();
        FRESH(); if (PH(7)) router_phase(F, args, l);
        GRID_BAR();
        FRESH(); if (PH(8)) dispatch_phase(F, l);
        GRID_BAR();
        const int nT = (int)__hip_atomic_load(F.ctl + CW_NT + l * 64, __ATOMIC_RELAXED, __HIP_MEMORY_SCOPE_AGENT);
        FRESH(); if (PH(9)) { SchedMoe S{(const char*)(F.ws + WS_H), (const char*)(F.ws + WS_W1) + (size_t)l * 32 * 2048 * 1024 * 2, (const int*)(F.ws + WS_TILEE), (const int*)(F.ws + WS_ROWMAP), nT, 8, F.G, F.c, (size_t)2048 * 1024 * 2};
          EpiW1 E{(bf16*)(F.ws + WS_ACT), args.in[I_B1] + (size_t)l * 32 * 2048};
          pg8::gemm_phase<EpiW1, SchedMoe, true, true>(F.lds, 1024, S, E); }
        GRID_BAR();
        FRESH(); if (PH(10)) { SchedMoe S{(const char*)(F.ws + WS_ACT), (const char*)(F.ws + WS_W2) + (size_t)l * 32 * 1024 * 1024 * 2, (const int*)(F.ws + WS_TILEE), nullptr, nT, 4, F.G, F.c, (size_t)1024 * 1024 * 2};
          EpiW2 E{(bf16*)(F.ws + WS_EOUT), args.in[I_B2] + (size_t)l * 32 * 1024};
          pg8::gemm_phase<EpiW2, SchedMoe, false, true>(F.lds, 1024, S, E); }
        GRID_BAR();
        FRESH(); if (PH(11)) combine_phase(F, args, l);
        if (l == 0) GRID_BAR();
    }
}

extern "C" void kernel_launch(void* const* d_in, const int* in_sizes, int n_in, void* d_out, int out_size, void* d_ws, size_t ws_size, hipStream_t stream) {
    static int grid = 0;
    if (grid == 0) {
        if (n_in != 18 || out_size != NLAT * DM || ws_size < WS_END) { fprintf(stderr, "kernel_launch: unexpected shapes (n_in %d out %d ws %zu need %zu)\n", n_in, out_size, ws_size, (size_t)WS_END); grid = -1; return; }
        int dev = 0, cus = 0;
        if (hipGetDevice(&dev) != hipSuccess || hipDeviceGetAttribute(&cus, hipDeviceAttributeMultiprocessorCount, dev) != hipSuccess) { grid = -1; return; }
        if (hipFuncSetAttribute((const void*)fwd_kernel, hipFuncAttributeMaxDynamicSharedMemorySize, LDS_BYTES) != hipSuccess) { fprintf(stderr, "kernel_launch: hipFuncSetAttribute failed\n"); grid = -1; return; }
        int per_cu = 0;
        if (hipOccupancyMaxActiveBlocksPerMultiprocessor(&per_cu, (const void*)fwd_kernel, 512, LDS_BYTES) != hipSuccess || per_cu < 1) { fprintf(stderr, "kernel_launch: occupancy query says %d\n", per_cu); }
        (void)hipGetLastError();
        grid = cus;
    }
    if (grid < 0) return;
    (void)hipMemsetAsync((char*)d_ws + WS_CTL, 0, CTL_ZERO_BYTES, stream);
    Args a{};
    for (int i = 0; i < 18; ++i) a.in[i] = (const float*)d_in[i];
    a.out = (float*)d_out; a.ws = (unsigned char*)d_ws;
    hipLaunchKernelGGL(fwd_kernel, dim3(grid), dim3(512), LDS_BYTES, stream, a);
}
```

```cpp
#include <hip/hip_runtime.h>
#include <cstdio>
#include <cstdint>

#define LAS __attribute__((address_space(3)))
#define GAS __attribute__((address_space(1)))
typedef unsigned short bf16;
typedef short bf16x8 __attribute__((ext_vector_type(8)));
typedef float f32x4 __attribute__((ext_vector_type(4)));
typedef float f32x2 __attribute__((ext_vector_type(2)));
typedef unsigned u32x4 __attribute__((ext_vector_type(4)));
typedef unsigned u32x2 __attribute__((ext_vector_type(2)));

#ifndef DBG
#define DBG 0
#endif
#ifndef PHMASK
#define PHMASK 0xFFFF
#endif
#define PH(k) ((PHMASK >> (k)) & 1)
#ifndef DUPMASK
#define DUPMASK 0
#endif
#define DUP(k, l) (1 + (((DUPMASK >> (k)) & 1) && (l) == 0))
#ifndef DIAG_A
#define DIAG_A 0
#endif
#ifndef DIAG_B
#define DIAG_B 0
#endif
#ifndef DIAG_A0
#define DIAG_A0 (DIAG_A - 1)
#endif
#ifndef DIAG_B0
#define DIAG_B0 (DIAG_B - 1)
#endif
#ifndef DIAG_SA
#define DIAG_SA 100
#endif
#ifndef DIAG_SB
#define DIAG_SB 1000
#endif

constexpr int DM = 1024, NB = 16, TL = 4096, TCX = 256;
constexpr int NCTX = NB * TCX, NLAT = NB * TL, MT = NCTX + NLAT;
constexpr int NQ = 2048;
constexpr int NE = 32;
constexpr int MAXTILES = 1120, MAXROWS = MAXTILES * 256;
constexpr float NORM_EPS = 1e-6f;

constexpr size_t MiB = 1u << 20;
constexpr size_t WS_CTL = 0, CTL_ZERO_BYTES = 1 * MiB;
constexpr size_t WS_WQ = 1 * MiB;
constexpr size_t WS_WF = 9 * MiB;
constexpr size_t WS_WO = 13 * MiB;
constexpr size_t WS_W1 = 17 * MiB;
constexpr size_t WS_W2 = 273 * MiB;
constexpr size_t WS_DFT = 401 * MiB;
constexpr size_t WS_DFTC = 465 * MiB;
constexpr size_t WS_RLIST = WS_DFT + 16 * MiB;
constexpr size_t WS_MODP = WS_DFT;
constexpr size_t WS_MODV = 473 * MiB;
constexpr size_t WS_A12 = 474 * MiB;
constexpr size_t WS_ROPE = 475 * MiB;
constexpr size_t WS_RT = 475 * MiB + 512 * 1024;
constexpr size_t WS_TOPE = 476 * MiB;
constexpr size_t WS_TOPG = 478 * MiB;
constexpr size_t WS_DEST = 480 * MiB;
constexpr size_t WS_ROWMAP = 482 * MiB;
constexpr size_t WS_TILEE = 484 * MiB;
constexpr size_t WS_XCTX = 485 * MiB;
constexpr size_t WS_H = 501 * MiB;
constexpr size_t WS_MIX = 637 * MiB;
constexpr size_t WS_QKVG = WS_MIX;
constexpr size_t WS_ZT = WS_MIX + 272 * MiB;
constexpr size_t WS_ZTC = WS_MIX + 400 * MiB;
constexpr size_t WS_OF = WS_MIX + 408 * MiB;
constexpr size_t WS_OB = WS_MIX + 476 * MiB;
constexpr size_t WS_CAT = WS_MIX + 544 * MiB;
constexpr size_t WS_ACT = WS_MIX;
constexpr size_t WS_EOUT = 1317 * MiB;
constexpr size_t WS_SS = 1877 * MiB;
constexpr size_t WS_XB = 1882 * MiB;
constexpr size_t WS_END = 2018 * MiB;
constexpr size_t WS_W1Q = WS_W1;
constexpr size_t WS_W1CS = WS_W1 + 128 * MiB;
constexpr size_t WS_W2Q = WS_W2;
constexpr size_t WS_W2CS = WS_W2 + 64 * MiB;
constexpr size_t WS_HSC = WS_W2 + 66 * MiB;
constexpr size_t WS_H8 = WS_H;
constexpr size_t WS_EOUT8 = WS_EOUT;
constexpr size_t WS_ES = WS_EOUT + 300 * MiB;
constexpr size_t WS_ACT8 = WS_ACT;

static_assert(WS_CAT + (size_t)MT * 1024 * 2 <= WS_EOUT && WS_ACT + (size_t)MAXROWS * 1024 * 2 <= WS_EOUT, "ws map");

constexpr int CW_BAR = 4096;
constexpr int CW_CNT = 8192;
constexpr int CW_CUR = 8448;
constexpr int CW_NT = 8704;
constexpr int CW_CHK = 9216;

constexpr int LDS_BYTES = 155648;
constexpr int LDS_MOE = 131072 + 4096;
constexpr int LDS_MISC = 155648 - 1024;

#if DIAG_A
#define SUBSTAMP(F, l, k) do { if ((l) == 0 && blockIdx.x == 0 && threadIdx.x == 0) ((volatile LAS unsigned long long*)((F).lds + LDS_MISC + 64))[32 + (k)] = wall_clock64(); } while (0)
#else
#define SUBSTAMP(F, l, k) do {} while (0)
#endif
__device__ __forceinline__ unsigned cvt_pk_bf16(float lo, float hi) { unsigned r; asm volatile("v_cvt_pk_bf16_f32 %0, %1, %2" : "=v"(r) : "v"(lo), "v"(hi)); return r; }
__device__ __forceinline__ float bf_lo(unsigned w) { return __uint_as_float(w << 16); }
__device__ __forceinline__ float bf_hi(unsigned w) { return __uint_as_float(w & 0xffff0000u); }
__device__ __forceinline__ float bf2f(bf16 b) { return __uint_as_float(((unsigned)b) << 16); }
__device__ __forceinline__ float wave_sum(float v) {
#pragma unroll
    for (int o = 1; o < 64; o <<= 1) v += __shfl_xor(v, o);
    return v;
}
__device__ __forceinline__ unsigned lds_add(LAS unsigned* p, unsigned v) { return __hip_atomic_fetch_add(p, v, __ATOMIC_RELAXED, __HIP_MEMORY_SCOPE_WORKGROUP); }
__device__ __forceinline__ void mx_scale(float amax, int& sb, float& inv) { int be = (int)((__float_as_uint(amax) >> 23) & 0xffu) - 7; be = be < 1 ? 1 : be; sb = be; inv = __uint_as_float((unsigned)(254 - be) << 23); }
__device__ __forceinline__ unsigned cvt4_fp8(float a, float b, float c, float d) { int p = __builtin_amdgcn_cvt_pk_fp8_f32(a, b, 0, false); p = __builtin_amdgcn_cvt_pk_fp8_f32(c, d, p, true); return (unsigned)p; }
#define LDS_WAIT() asm volatile("s_waitcnt lgkmcnt(0)" ::: "memory")
#define VM_WAIT() asm volatile("s_waitcnt vmcnt(0)" ::: "memory")

#define XB_TMO      128
#define XB_XCNT(j)  (256  + 64 * (j))
#define XB_XSUB(j)  (1280 + 64 * (j))
#define XB_XGEN(j)  (2304 + 64 * (j))
#define XB_TOP      3328
#define XB_TOPGEN   3392
#define XCD_BAR_WORDS 3456
#define XB_SPIN_CAP (1u << 18)

__device__ __forceinline__ unsigned xb_ld(unsigned* p)              { return __hip_atomic_load(p, __ATOMIC_RELAXED, __HIP_MEMORY_SCOPE_AGENT); }
__device__ __forceinline__ unsigned xb_add(unsigned* p, unsigned v) { return __hip_atomic_fetch_add(p, v, __ATOMIC_RELAXED, __HIP_MEMORY_SCOPE_AGENT); }
__device__ __forceinline__ unsigned xb_xcc_id() { return (unsigned)__builtin_amdgcn_s_getreg((3 << 11) | 20) & 0xFu; }
#define XB_SPIN(cond, bar) do { unsigned _sp = 0; while (cond) { __builtin_amdgcn_s_sleep(1); \
    if ((++_sp & 255u) == 0u) { if (xb_ld(&(bar)[XB_TMO])) break; if (_sp > XB_SPIN_CAP) { atomicAdd(&(bar)[XB_TMO], 1u); break; } } } } while (0)

struct XcdBarrier {
    unsigned* bar; unsigned x;
    volatile LAS unsigned* st;
};
__device__ __forceinline__ XcdBarrier xcd_barrier_post(unsigned* bar, volatile LAS unsigned* st) {
    XcdBarrier b; b.bar = bar; b.x = xb_xcc_id(); b.st = st;
    if (threadIdx.x == 0) (void)xb_add(&bar[XB_XCNT(b.x)], 1u);
    return b;
}
__device__ __forceinline__ void xcd_barrier_complete(unsigned* bar, unsigned x, unsigned& nloc, unsigned& nx) {
    const unsigned G = gridDim.x * gridDim.y * gridDim.z;
    unsigned sum, cnt, mine, sp = 0u;
    for (;;) {
        sum = 0u; cnt = 0u; mine = 0u;
#pragma unroll
        for (unsigned j = 0; j < 16; ++j) { const unsigned c = xb_ld(&bar[XB_XCNT(j)]); sum += c; cnt += (c > 0u) ? 1u : 0u; mine = (j == x) ? c : mine; }
        if (sum == G) break;
        __builtin_amdgcn_s_sleep(1);
        if ((++sp & 255u) == 0u) { if (xb_ld(&bar[XB_TMO])) break; if (sp > XB_SPIN_CAP) { atomicAdd(&bar[XB_TMO], 1u); break; } }
    }
    nloc = mine > 0u ? mine : 1u; nx = cnt > 0u ? cnt : 1u;
}
__device__ __forceinline__ void xcd_barrier(const XcdBarrier& b) {
    asm volatile("s_waitcnt vmcnt(0)" ::: "memory");
    __syncthreads();
    if (threadIdx.x == 0) {
        unsigned* bar = b.bar;
        __builtin_amdgcn_s_waitcnt(0);
        unsigned nloc = b.st[0], nx = b.st[1];
        if (nloc == 0u) { xcd_barrier_complete(bar, b.x, nloc, nx); b.st[0] = nloc; b.st[1] = nx; }
        const unsigned old = xb_add(&bar[XB_XSUB(b.x)], 1u);
        const unsigned gen = old / nloc;
        if (old + 1u == (gen + 1u) * nloc) {
            __builtin_amdgcn_fence(__ATOMIC_RELEASE, "agent");
            asm volatile("s_waitcnt vmcnt(0)" ::: "memory");
            const unsigned og = xb_add(&bar[XB_TOP], 1u);
            const unsigned tg = og / nx;
            if (og + 1u == (tg + 1u) * nx) xb_add(&bar[XB_TOPGEN], 1u);
            else XB_SPIN(xb_ld(&bar[XB_TOPGEN]) == tg, bar);
            __builtin_amdgcn_fence(__ATOMIC_ACQUIRE, "agent");
            xb_add(&bar[XB_XGEN(b.x)], 1u);
            asm volatile("s_waitcnt vmcnt(0)" ::: "memory");
        } else {
            XB_SPIN(xb_ld(&bar[XB_XGEN(b.x)]) == gen, bar);
            __builtin_amdgcn_fence(__ATOMIC_ACQUIRE, "agent");
            asm volatile("s_waitcnt vmcnt(0)" ::: "memory");
        }
    }
    __syncthreads();
}

namespace pg8 {
constexpr int BM = 256, BK = 64, HALF = 128, HTB = HALF * BK * 2, STAGE_BYTES = 8 * HTB, NXCD = 8, WGM = 8;
__host__ __device__ __forceinline__ int lds_byte(int r, int c) { const int st = (r >> 4) * 2 + (c >> 5), rr = r & 15, cc = c & 31, ob = rr * 64 + cc * 2; return st * 1024 + (ob ^ (((ob >> 9) & 1) << 5)); }
__host__ __device__ __forceinline__ void stage_rc(int b, int& R, int& C) { const int st = b / 1024, sb = b % 1024, swz = sb ^ (((sb >> 9) & 1) << 5); R = (st >> 1) * 16 + swz / 64; C = (st & 1) * 32 + (swz % 64) / 2; }
__host__ __device__ __forceinline__ int perm32(int rho) { const int n = rho >> 4, i = rho & 15; return 8 * (i >> 2) + 4 * n + (i & 3); }

struct Unit { const char* A; const char* B; int pm, pn, e; };

__device__ __forceinline__ void tile_of(int L, int nM, int nN, int& pm, int& pn) {
    const int nwg = nM * nN; int wgid = L;
    { const int q = nwg / NXCD, r = nwg % NXCD, xcd = wgid % NXCD, off = wgid / NXCD; wgid = (xcd < r ? xcd * (q + 1) : r * (q + 1) + (xcd - r) * q) + off; }
    const int nig = WGM * nN, gid = wgid / nig, fm = gid * WGM, gsz = (nM - fm) < WGM ? (nM - fm) : WGM;
    pm = fm + ((wgid % nig) % gsz); pn = (wgid % nig) / gsz;
}

template <class Epi, class Sched, bool GATHER, bool ALIGN_EPI, bool BPERM = false>
__device__ __forceinline__ void gemm_phase(LAS unsigned char* lds, const int K, const Sched& S, const Epi& E) {
    int tid_ = threadIdx.x; asm volatile("" : "+v"(tid_));
    const int tid = tid_, wid = __builtin_amdgcn_readfirstlane(tid >> 6), lane = tid & 63, wr = wid >> 2, wc = wid & 3, fr = lane & 15, fq = lane >> 4;
    const int nt = K / BK;
    unsigned voffBn[2][2], voffBp[2][2], cAo[2][2], nAo[2][2]; int Rl[2], Cl[2];
#pragma unroll
    for (int i = 0; i < 2; ++i) { int R, C; stage_rc(tid * 16 + i * 8192, R, C); Rl[i] = R; Cl[i] = C; const int Rb = Epi::PERM ? ((R & ~31) + perm32(R & 31)) : R;
        voffBn[0][i] = (unsigned)(Rb * K + C) * 2u; voffBn[1][i] = (unsigned)((Rb + HALF) * K + C) * 2u;
        voffBp[0][i] = (unsigned)((64 * (Rb & 63) + (Rb >> 6)) * K + C) * 2u - voffBn[0][i]; voffBp[1][i] = (unsigned)((64 * (Rb & 63) + 2 + (Rb >> 6)) * K + C) * 2u - voffBn[1][i];
        cAo[0][i] = (unsigned)(R * K + C) * 2u; cAo[1][i] = (unsigned)((R + HALF) * K + C) * 2u; nAo[0][i] = cAo[0][i]; nAo[1][i] = cAo[1][i]; }
    const size_t kstep = (size_t)(BK * 2);
    const unsigned ldsw = (unsigned)wid * 1024u;
    const int aoff = lds_byte(wr * 64 + fr, fq * 8), boff = lds_byte(wc * 32 + fr, fq * 8);
#define PG8_SA(b, h) (((b) * 2 + (h)) * HTB)
#define PG8_SB(b, h) ((4 + (b) * 2 + (h)) * HTB)
#define PG8_STAGE_B(bufoff, gbase, offs, h) do { _Pragma("unroll") for (int _i = 0; _i < 2; ++_i) { unsigned _o = (offs)[h][_i]; asm volatile("" : "+v"(_o));     \
        __builtin_amdgcn_global_load_lds((const unsigned*)((const char*)(gbase) + _o), (LAS unsigned*)(lds + (bufoff) + ldsw + _i * 8192), 16, 0, 0); } } while (0)
#define PG8_STAGE_A(bufoff, gbase, offs, h) do { _Pragma("unroll") for (int _i = 0; _i < 2; ++_i) { unsigned _o = (offs)[h][_i]; asm volatile("" : "+v"(_o)); \
        __builtin_amdgcn_global_load_lds((const unsigned*)((const char*)(gbase) + _o), (LAS unsigned*)(lds + (bufoff) + ldsw + _i * 8192), 16, 0, 0); } } while (0)
#define PG8_LDA(dst, b, h) do { _Pragma("unroll") for (int m = 0; m < 4; ++m) _Pragma("unroll") for (int k = 0; k < 2; ++k) dst[m][k] = *(const LAS bf16x8*)(lds + PG8_SA(b, h) + aoff + m * 2048 + k * 1024); } while (0)
#define PG8_LDB(dst, b, h) do { _Pragma("unroll") for (int n = 0; n < 2; ++n) _Pragma("unroll") for (int k = 0; k < 2; ++k) dst[n][k] = *(const LAS bf16x8*)(lds + PG8_SB(b, h) + boff + n * 2048 + k * 1024); } while (0)
#define PG8_MMA(ai, bj, At, Bt) do { __builtin_amdgcn_s_setprio(1); _Pragma("unroll") for (int m = 0; m < 4; ++m) _Pragma("unroll") for (int n = 0; n < 2; ++n) _Pragma("unroll") for (int k = 0; k < 2; ++k) \
        acc[ai][bj][m][n] = __builtin_amdgcn_mfma_f32_16x16x32_bf16(Bt[n][k], At[m][k], acc[ai][bj][m][n], 0, 0, 0); __builtin_amdgcn_s_setprio(0); } while (0)
#define PG8_WAIT_V(n) asm volatile("s_waitcnt vmcnt(" #n ")" ::: "memory")
#define PG8_WAIT_L(n) asm volatile("s_waitcnt lgkmcnt(" #n ")" ::: "memory")
#define PG8_BAR __builtin_amdgcn_s_barrier()
#define PG8_SCHED __builtin_amdgcn_sched_barrier(0)
    Unit cur, nxt; int ui = 0;
    if (!S.next(0, cur)) return;
    if constexpr (GATHER) S.rowoffs(cur, Rl, Cl, cAo);
    unsigned cfl = (BPERM && cur.e == 2) ? 1u : 0u, nfl = cfl;
    unsigned cBo[2][2];
#pragma unroll
    for (int h = 0; h < 2; ++h)
#pragma unroll
        for (int i = 0; i < 2; ++i) cBo[h][i] = BPERM ? voffBn[h][i] + cfl * voffBp[h][i] : voffBn[h][i];
    f32x4 acc[2][2][4][2];
#pragma unroll
    for (int a = 0; a < 2; ++a)
#pragma unroll
        for (int b = 0; b < 2; ++b)
#pragma unroll
            for (int m = 0; m < 4; ++m)
#pragma unroll
                for (int n = 0; n < 2; ++n) acc[a][b][m][n] = (f32x4){0.f, 0.f, 0.f, 0.f};
    bf16x8 At[4][2], B0[2][2], B1[2][2];
    const char* cA = cur.A; const char* cB = cur.B;
    PG8_STAGE_B(PG8_SB(0, 0), cB, cBo, 0); PG8_STAGE_B(PG8_SB(0, 1), cB, cBo, 1); PG8_STAGE_A(PG8_SA(0, 0), cA, cAo, 0); PG8_STAGE_A(PG8_SA(0, 1), cA, cAo, 1);
    if (wr == 1) PG8_BAR;
    PG8_WAIT_V(2); PG8_BAR;
    PG8_STAGE_B(PG8_SB(1, 0), cB + kstep, cBo, 0); PG8_STAGE_A(PG8_SA(1, 0), cA + kstep, cAo, 0); PG8_STAGE_B(PG8_SB(1, 1), cB + kstep, cBo, 1);
    PG8_WAIT_V(6); PG8_BAR;
    for (;;) {
        const bool has_next = S.next(ui + 1, nxt);
        const char* nA = has_next ? nxt.A : cA; const char* nB = has_next ? nxt.B : cB;
        if constexpr (GATHER) { if (has_next) S.rowoffs(nxt, Rl, Cl, nAo); else { nAo[0][0] = cAo[0][0]; nAo[0][1] = cAo[0][1]; nAo[1][0] = cAo[1][0]; nAo[1][1] = cAo[1][1]; } }
        if constexpr (BPERM) nfl = has_next ? ((nxt.e == 2) ? 1u : 0u) : cfl;
        for (int t = 0; t < nt; t += 2) {
            const bool last = (t == nt - 2);
            const char* a1 = cA + (size_t)(t + 1) * kstep;
            const char* a2 = last ? nA : cA + (size_t)(t + 2) * kstep; const char* b2 = last ? nB : cB + (size_t)(t + 2) * kstep;
            const char* a3 = a2 + kstep; const char* b3 = b2 + kstep;
            unsigned o2[2][2];
#pragma unroll
            for (int h = 0; h < 2; ++h)
#pragma unroll
                for (int i = 0; i < 2; ++i) o2[h][i] = (GATHER && last) ? nAo[h][i] : cAo[h][i];
            unsigned ob2[2][2]; const unsigned fl2 = last ? nfl : cfl;
#pragma unroll
            for (int h = 0; h < 2; ++h)
#pragma unroll
                for (int i = 0; i < 2; ++i) ob2[h][i] = BPERM ? voffBn[h][i] + fl2 * voffBp[h][i] : voffBn[h][i];
            PG8_LDB(B0, 0, 0); PG8_LDB(B1, 0, 1); PG8_SCHED; PG8_LDA(At, 0, 0); PG8_STAGE_A(PG8_SA(1, 1), a1, cAo, 1);
            PG8_WAIT_V(8); PG8_WAIT_L(0); PG8_BAR; PG8_MMA(0, 0, At, B0); PG8_MMA(0, 1, At, B1); PG8_BAR; PG8_SCHED;
            PG8_LDA(At, 0, 1); PG8_STAGE_B(PG8_SB(0, 0), b2, ob2, 0); PG8_STAGE_B(PG8_SB(0, 1), b2, ob2, 1); PG8_STAGE_A(PG8_SA(0, 0), a2, o2, 0);
            PG8_WAIT_V(8); PG8_WAIT_L(0); PG8_BAR; PG8_MMA(1, 0, At, B0); PG8_MMA(1, 1, At, B1); PG8_BAR; PG8_SCHED;
            PG8_LDB(B0, 1, 0); PG8_LDB(B1, 1, 1); PG8_SCHED; PG8_LDA(At, 1, 0); PG8_STAGE_A(PG8_SA(0, 1), a2, o2, 1);
            PG8_WAIT_V(8); PG8_WAIT_L(0); PG8_BAR; PG8_MMA(0, 0, At, B0); PG8_MMA(0, 1, At, B1); PG8_BAR; PG8_SCHED;
            PG8_LDA(At, 1, 1); PG8_STAGE_B(PG8_SB(1, 0), b3, ob2, 0); PG8_STAGE_B(PG8_SB(1, 1), b3, ob2, 1); PG8_STAGE_A(PG8_SA(1, 0), a3, o2, 0);
            PG8_WAIT_V(8); PG8_WAIT_L(0); PG8_BAR; PG8_MMA(1, 0, At, B0); PG8_MMA(1, 1, At, B1); PG8_BAR; PG8_SCHED;
        }
        if constexpr (ALIGN_EPI) { if (wr == 0) PG8_BAR; }
        E(acc, cur, wr, wc, fr, fq);
        if (!has_next) break;
#pragma unroll
        for (int a = 0; a < 2; ++a)
#pragma unroll
            for (int b = 0; b < 2; ++b)
#pragma unroll
                for (int m = 0; m < 4; ++m)
#pragma unroll
                    for (int n = 0; n < 2; ++n) acc[a][b][m][n] = (f32x4){0.f, 0.f, 0.f, 0.f};
        cur = nxt; cA = nA; cB = nB; ++ui;
        if constexpr (GATHER) { cAo[0][0] = nAo[0][0]; cAo[0][1] = nAo[0][1]; cAo[1][0] = nAo[1][0]; cAo[1][1] = nAo[1][1]; }
        if constexpr (BPERM) { cfl = nfl;
#pragma unroll
            for (int h = 0; h < 2; ++h)
#pragma unroll
                for (int i = 0; i < 2; ++i) cBo[h][i] = voffBn[h][i] + cfl * voffBp[h][i]; }
        if constexpr (ALIGN_EPI) { if (wr == 1) PG8_BAR; }
    }
    PG8_WAIT_V(0);
    if constexpr (!ALIGN_EPI) { if (wr == 0) PG8_BAR; }
    PG8_BAR;
#undef PG8_SA
#undef PG8_SB
#undef PG8_STAGE_A
#undef PG8_STAGE_B
#undef PG8_LDA
#undef PG8_LDB
#undef PG8_MMA
#undef PG8_WAIT_V
#undef PG8_WAIT_L
#undef PG8_BAR
#undef PG8_SCHED
}

typedef int v8i_t __attribute__((ext_vector_type(8)));
typedef int v4i_t __attribute__((ext_vector_type(4)));
__device__ __forceinline__ v8i_t cat8(const bf16x8 lo, const bf16x8 hi) { return __builtin_shufflevector(__builtin_bit_cast(v4i_t, lo), __builtin_bit_cast(v4i_t, hi), 0, 1, 2, 3, 4, 5, 6, 7); }
template <class Epi, class Sched, bool GATHER>
__device__ __forceinline__ void gemm_phase_mx(LAS unsigned char* lds, const Sched& S, const Epi& E) {
    int tid_ = threadIdx.x; asm volatile("" : "+v"(tid_));
    const int tid = tid_, wid = __builtin_amdgcn_readfirstlane(tid >> 6), lane = tid & 63, wr = wid >> 2, wc = wid & 3, fr = lane & 15, fq = lane >> 4;
    constexpr int KB = 1024; int nt = 8; asm volatile("" : "+s"(nt));
    unsigned voffBn[2][2], cAo[2][2], nAo[2][2];
#pragma unroll
    for (int i = 0; i < 2; ++i) { int R, C; stage_rc(tid * 16 + i * 8192, R, C); const int Rb = Epi::PERM ? ((R & ~31) + perm32(R & 31)) : R;
        voffBn[0][i] = (unsigned)(Rb * KB + 2 * C); voffBn[1][i] = (unsigned)((Rb + HALF) * KB + 2 * C);
        cAo[0][i] = (unsigned)(R * KB + 2 * C); cAo[1][i] = (unsigned)((R + HALF) * KB + 2 * C); nAo[0][i] = cAo[0][i]; nAo[1][i] = cAo[1][i]; }
    const size_t kstep = 128;
    const unsigned ldsw = (unsigned)wid * 1024u;
    const int aoff = lds_byte(wr * 64 + fr, fq * 8), boff = lds_byte(wc * 32 + fr, fq * 8);
    int one = 0x7f7f7f7f; asm volatile("" : "+v"(one));
#define PG8_SA(b, h) (((b) * 2 + (h)) * HTB)
#define PG8_SB(b, h) ((4 + (b) * 2 + (h)) * HTB)
#define PG8_STAGE_B(bufoff, gbase, offs, h) do { _Pragma("unroll") for (int _i = 0; _i < 2; ++_i) { unsigned _o = (offs)[h][_i]; asm volatile("" : "+v"(_o));     \
        __builtin_amdgcn_global_load_lds((const unsigned*)((const char*)(gbase) + _o), (LAS unsigned*)(lds + (bufoff) + ldsw + _i * 8192), 16, 0, 0); } } while (0)
#define PG8_STAGE_A(bufoff, gbase, offs, h) PG8_STAGE_B(bufoff, gbase, offs, h)
#define PG8_LDA(dst, b, h) do { _Pragma("unroll") for (int m = 0; m < 4; ++m) dst[m] = cat8(*(const LAS bf16x8*)(lds + PG8_SA(b, h) + aoff + m * 2048), *(const LAS bf16x8*)(lds + PG8_SA(b, h) + aoff + m * 2048 + 1024)); } while (0)
#define PG8_LDB(dst, b, h) do { _Pragma("unroll") for (int n = 0; n < 2; ++n) dst[n] = cat8(*(const LAS bf16x8*)(lds + PG8_SB(b, h) + boff + n * 2048), *(const LAS bf16x8*)(lds + PG8_SB(b, h) + boff + n * 2048 + 1024)); } while (0)
#define PG8_MXA(accv, bt, at) asm volatile("v_mfma_scale_f32_16x16x128_f8f6f4 %0, %1, %2, %0, %3, %3 op_sel_hi:[0,0,0]" : "+v"(accv) : "v"(bt), "v"(at), "v"(one))
#define PG8_MMA(ai, bj, At, Bt) do { __builtin_amdgcn_s_setprio(1); _Pragma("unroll") for (int m = 0; m < 4; ++m) _Pragma("unroll") for (int n = 0; n < 2; ++n) PG8_MXA(acc[ai][bj][m][n], Bt[n], At[m]); __builtin_amdgcn_s_setprio(0); } while (0)
#define PG8_WAIT_V(n) asm volatile("s_waitcnt vmcnt(" #n ")" ::: "memory")
#define PG8_WAIT_L(n) asm volatile("s_waitcnt lgkmcnt(" #n ")" ::: "memory")
#define PG8_BAR __builtin_amdgcn_s_barrier()
#define PG8_SCHED __builtin_amdgcn_sched_barrier(0)
    constexpr int SIDE = 131072;
#define PG8_SIDE(u_, slot_) do { const float* sp_ = (wid < 4) ? E.sideA(u_) + 64 * wid : E.sideB(u_) + 64 * (wid - 4); \
        __builtin_amdgcn_global_load_lds((const unsigned*)(sp_ + lane), (LAS unsigned*)(lds + SIDE + (slot_) * 2048 + wid * 256), 4, 0, 0); } while (0)
    Unit cur, nxt; int ui = 0;
    if (!S.next(0, cur)) return;
    if constexpr (GATHER) S.rowoffs(cur, tid, cAo);
    PG8_SIDE(cur, 0);
    f32x4 acc[2][2][4][2];
#pragma unroll
    for (int a = 0; a < 2; ++a)
#pragma unroll
        for (int b = 0; b < 2; ++b)
#pragma unroll
            for (int m = 0; m < 4; ++m)
#pragma unroll
                for (int n = 0; n < 2; ++n) acc[a][b][m][n] = (f32x4){0.f, 0.f, 0.f, 0.f};
    v8i_t At[4], B0[2], B1[2];
    const char* cA = cur.A; const char* cB = cur.B;
    PG8_STAGE_B(PG8_SB(0, 0), cB, voffBn, 0); PG8_STAGE_B(PG8_SB(0, 1), cB, voffBn, 1); PG8_STAGE_A(PG8_SA(0, 0), cA, cAo, 0); PG8_STAGE_A(PG8_SA(0, 1), cA, cAo, 1);
    if (wr == 1) PG8_BAR;
    PG8_WAIT_V(2); PG8_BAR;
    PG8_STAGE_B(PG8_SB(1, 0), cB + kstep, voffBn, 0); PG8_STAGE_A(PG8_SA(1, 0), cA + kstep, cAo, 0); PG8_STAGE_B(PG8_SB(1, 1), cB + kstep, voffBn, 1);
    PG8_WAIT_V(6); PG8_BAR;
    for (;;) {
        const bool has_next = S.next(ui + 1, nxt);
        const char* nA = has_next ? nxt.A : cA; const char* nB = has_next ? nxt.B : cB;
        if constexpr (GATHER) { if (has_next) S.rowoffs(nxt, tid, nAo); else { nAo[0][0] = cAo[0][0]; nAo[0][1] = cAo[0][1]; nAo[1][0] = cAo[1][0]; nAo[1][1] = cAo[1][1]; } }
        for (int t = 0; t < nt; t += 2) {
            const bool last = (t == nt - 2);
            const char* a1 = cA + (size_t)(t + 1) * kstep;
            const char* a2 = last ? nA : cA + (size_t)(t + 2) * kstep; const char* b2 = last ? nB : cB + (size_t)(t + 2) * kstep;
            const char* a3 = a2 + kstep; const char* b3 = b2 + kstep;
            PG8_LDB(B0, 0, 0); PG8_LDB(B1, 0, 1); PG8_SCHED; PG8_LDA(At, 0, 0); PG8_STAGE_A(PG8_SA(1, 1), a1, cAo, 1);
            if constexpr (GATHER) { if (last) { cAo[0][0] = nAo[0][0]; cAo[0][1] = nAo[0][1]; cAo[1][0] = nAo[1][0]; cAo[1][1] = nAo[1][1]; } }
            PG8_WAIT_V(8); PG8_WAIT_L(0); PG8_BAR; if (t == 0 && has_next) PG8_SIDE(nxt, (ui + 1) & 1); PG8_MMA(0, 0, At, B0); PG8_MMA(0, 1, At, B1); PG8_BAR; PG8_SCHED;
            PG8_LDA(At, 0, 1); PG8_STAGE_B(PG8_SB(0, 0), b2, voffBn, 0); PG8_STAGE_B(PG8_SB(0, 1), b2, voffBn, 1); PG8_STAGE_A(PG8_SA(0, 0), a2, cAo, 0);
            PG8_WAIT_V(8); PG8_WAIT_L(0); PG8_BAR; PG8_MMA(1, 0, At, B0); PG8_MMA(1, 1, At, B1); PG8_BAR; PG8_SCHED;
            PG8_LDB(B0, 1, 0); PG8_LDB(B1, 1, 1); PG8_SCHED; PG8_LDA(At, 1, 0); PG8_STAGE_A(PG8_SA(0, 1), a2, cAo, 1);
            PG8_WAIT_V(8); PG8_WAIT_L(0); PG8_BAR; PG8_MMA(0, 0, At, B0); PG8_MMA(0, 1, At, B1); PG8_BAR; PG8_SCHED;
            PG8_LDA(At, 1, 1); PG8_STAGE_B(PG8_SB(1, 0), b3, voffBn, 0); PG8_STAGE_B(PG8_SB(1, 1), b3, voffBn, 1); PG8_STAGE_A(PG8_SA(1, 0), a3, cAo, 0);
            PG8_WAIT_V(8); PG8_WAIT_L(0); PG8_BAR; PG8_MMA(1, 0, At, B0); PG8_MMA(1, 1, At, B1); PG8_BAR; PG8_SCHED;
        }
        if (wr == 0) PG8_BAR;
        asm volatile("s_nop 15\n\ts_nop 15" ::: "memory");
        E(acc, cur, wr, wc, fr, fq, (const LAS float*)(lds + SIDE + (ui & 1) * 2048));
        if (!has_next) break;
#pragma unroll
        for (int a = 0; a < 2; ++a)
#pragma unroll
            for (int b = 0; b < 2; ++b)
#pragma unroll
                for (int m = 0; m < 4; ++m)
#pragma unroll
                    for (int n = 0; n < 2; ++n) acc[a][b][m][n] = (f32x4){0.f, 0.f, 0.f, 0.f};
        cur = nxt; cA = nA; cB = nB; ++ui;
        if (wr == 1) PG8_BAR;
    }
    PG8_WAIT_V(0);
    PG8_BAR;
#undef PG8_SA
#undef PG8_SB
#undef PG8_STAGE_A
#undef PG8_STAGE_B
#undef PG8_LDA
#undef PG8_LDB
#undef PG8_MXA
#undef PG8_SIDE
#undef PG8_MMA
#undef PG8_WAIT_V
#undef PG8_WAIT_L
#undef PG8_BAR
#undef PG8_SCHED
}
}
using pg8::Unit;
typedef const f32x4 (&AccRef)[2][2][4][2];

struct Args { const float* in[18]; float* out; unsigned char* ws; };
enum { I_X = 0, I_C, I_CTX, I_CCTX, I_MODW, I_MODB, I_NORMW, I_WIN, I_WOUT, I_DECAY, I_RNW, I_RW, I_RB, I_W1, I_B1, I_W2, I_B2, I_FNW };

struct Frame {
    LAS unsigned char* lds;
    unsigned char* ws;
    unsigned* ctl;
    int tid, lane, wave, G, c;
};
__device__ __forceinline__ int batch_of_row(int r) { return r < NCTX ? 16 : ((r - NCTX) >> 12); }

struct SchedReg {
    const char* A; const char* B; int nM, nN, pm0, G, c; size_t tstep;
    __device__ __forceinline__ bool next(int i, Unit& u) const {
        const int L = i * G + c; if (L >= nM * nN) return false;
        int pm, pn; pg8::tile_of(L, nM, nN, pm, pn); u.pm = pm + pm0; u.pn = pn; u.e = 0;
        u.A = A + (size_t)u.pm * tstep; u.B = B + (size_t)pn * tstep; return true; }
};
struct SchedInproj {
    const char* H; const char* Wq; const char* Wf; int G, c;
    __device__ __forceinline__ bool next(int i, Unit& u) const {
        const int L = i * G + c; constexpr size_t tstep = (size_t)256 * 1024 * 2;
        if (L >= 3264) return false;
        int pm, pn;
        if (L < 2176) { pg8::tile_of(L, 272, 8, pm, pn); u.e = 0; u.A = H + (size_t)pm * tstep; u.B = Wq + (size_t)pn * tstep; }
        else { pg8::tile_of(L - 2176, 4, 272, pm, pn); u.A = Wf + (size_t)pm * tstep;
               if (pn < 16) { u.e = 1; u.B = H + (size_t)pn * tstep; }
               else { const int pl = pn - 16, b = pl >> 4, q = pl & 15; u.e = 2; u.B = H + (size_t)(NCTX + b * 4096 + 4 * q) * 2048; } }
        u.pm = pm; u.pn = pn; return true; }
};
struct SchedDft {
    const char* Dm; const char* ZT; int G, c;
    __device__ __forceinline__ bool next(int i, Unit& u) const {
        const int L = i * G + c; if (L >= 512) return false;
        const int pm = L & 15, bp = L >> 4, b = bp >> 1, pn = bp & 1; constexpr size_t tstep = (size_t)256 * 8192 * 2;
        u.pm = pm; u.pn = pn; u.e = b; u.A = Dm + (size_t)pm * tstep; u.B = ZT + (size_t)b * ((size_t)512 * 8192 * 2) + (size_t)pn * tstep; return true; }
};
struct SchedDftC {
    const char* Dm; const char* ZT; int G, c;
    __device__ __forceinline__ bool next(int i, Unit& u) const {
        const int L = i * G + c; if (L >= 32) return false;
        const int b = L >> 1, pn = L & 1;
        u.pm = 0; u.pn = pn; u.e = b; u.A = Dm; u.B = ZT + (size_t)b * ((size_t)512 * 512 * 2) + (size_t)pn * ((size_t)256 * 512 * 2); return true; }
};
struct SchedMoe {
    const char* A; const char* B; const int* tile_e; const int* rowmap; int nT, nN, G, c; size_t strideE;
    __device__ __forceinline__ bool next(int i, Unit& u) const {
        const int L = i * G + c; if (L >= nT * nN) return false;
        int pm, pn; pg8::tile_of(L, nT, nN, pm, pn); constexpr size_t tstep = (size_t)256 * 1024 * 2;
        const int e = __builtin_amdgcn_readfirstlane(tile_e[pm]);
        u.pm = pm; u.pn = pn; u.e = e; u.A = A + (rowmap ? (size_t)0 : (size_t)pm * tstep); u.B = B + (size_t)e * strideE + (size_t)pn * tstep; return true; }
    __device__ __forceinline__ void rowoffs(const Unit& u, const int (&Rl)[2], const int (&Cl)[2], unsigned (&o)[2][2]) const {
#pragma unroll
        for (int h = 0; h < 2; ++h)
#pragma unroll
            for (int i = 0; i < 2; ++i) o[h][i] = (unsigned)rowmap[u.pm * 256 + h * 128 + Rl[i]] * 2048u + (unsigned)Cl[i] * 2u; }
};

struct SchedMoeQ {
    const char* A; const char* B; const LAS int* tab; const int* rlist; int row_pad, nT, nN, G, c; size_t strideE;
    __device__ __forceinline__ bool next(int i, Unit& u) const {
        const int L = i * G + c; if (L >= nT * nN) return false;
        int pm, pn; pg8::tile_of(L, nT, nN, pm, pn); constexpr size_t tstep = (size_t)256 * 1024;
        const int e = __builtin_amdgcn_readfirstlane(tab[pm]);
        u.pm = pm; u.pn = pn; u.e = e; u.A = A + (rlist ? (size_t)0 : (size_t)pm * tstep); u.B = B + (size_t)e * strideE + (size_t)pn * tstep; return true; }
    __device__ __forceinline__ void rowoffs(const Unit& u, int tid, unsigned (&o)[2][2]) const {
        const int cnt = __builtin_amdgcn_readfirstlane(tab[1120 + u.e]), t0 = __builtin_amdgcn_readfirstlane(tab[1152 + u.e]); const int* lst = rlist + (size_t)u.e * MT;
#pragma unroll
        for (int i = 0; i < 2; ++i) { int R, C; pg8::stage_rc(tid * 16 + i * 8192, R, C);
#pragma unroll
            for (int h = 0; h < 2; ++h) { const int idx = (u.pm - t0) * 256 + h * 128 + R; const int row = idx < cnt ? lst[idx] : row_pad; o[h][i] = (unsigned)row * 1024u + (unsigned)C * 2u; } } }
};
__device__ __forceinline__ int moe_tables(Frame& F, int l) {
    LAS int* tab = (LAS int*)(F.lds + LDS_MOE);
    if (F.tid < 32) tab[1120 + F.tid] = (int)__hip_atomic_load(F.ctl + CW_CUR + l * 64 + F.tid, __ATOMIC_RELAXED, __HIP_MEMORY_SCOPE_AGENT);
    __syncthreads();
    if (F.tid == 0) { int t = 0; for (int e = 0; e < 32; ++e) { tab[1152 + e] = t; t += (tab[1120 + e] + 255) >> 8; } tab[1184] = t; }
    __syncthreads();
    const int nT = tab[1184];
    for (int t = F.tid; t < nT; t += 512) { int e = 0;
#pragma unroll 1
        for (int q = 1; q < 32; ++q) e += (tab[1152 + q] <= t) ? 1 : 0;
        tab[t] = e; }
    __syncthreads();
    return __builtin_amdgcn_readfirstlane(nT);
}

__device__ __forceinline__ u32x4 pack8(const f32x4& v0, const f32x4& v1) { u32x4 w; w.x = cvt_pk_bf16(v0[0], v0[1]); w.y = cvt_pk_bf16(v0[2], v0[3]); w.z = cvt_pk_bf16(v1[0], v1[1]); w.w = cvt_pk_bf16(v1[2], v1[3]); return w; }

struct EpiInproj {
    static constexpr bool PERM = true;
    bf16* QKVG; bf16* ZT; bf16* ZTC; const float* rope;
    __device__ __forceinline__ void operator()(AccRef acc, const Unit& u, int wr, int wc, int fr, int fq) const {
        const int row0 = u.pm * 256 + wr * 64 + fr, col0 = u.pn * 256 + wc * 32 + 8 * fq;
        if (u.e == 0) {
            const int kind = u.pn >> 1; const bool lat = u.pm >= 16; const float sc = kind == 0 ? 0.125f : 1.0f; const bool dorope = (kind < 2) && lat;
#pragma unroll
            for (int ai = 0; ai < 2; ++ai) {
                f32x4 rc[4][2];
                if (dorope) {
#pragma unroll
                    for (int m = 0; m < 4; ++m) { const int t = (row0 + ai * 128 + m * 16 - NCTX) & 4095; const int pos = (wc & 1) ? (t & 63) : (t >> 6); const f32x4* rp = (const f32x4*)(rope + pos * 32 + fq * 8); rc[m][0] = rp[0]; rc[m][1] = rp[1]; } }
#pragma unroll
                for (int m = 0; m < 4; ++m) {
                    const int row = row0 + ai * 128 + m * 16;
                    f32x4 cs0 = (f32x4){1.f, 0.f, 1.f, 0.f}, cs1 = cs0;
                    if (dorope) { cs0 = rc[m][0]; cs1 = rc[m][1]; }
                    bf16* rowp = QKVG + (((size_t)(kind * 8 + 4 * (u.pn & 1) + (wc >> 1)) * MT + row) * 64 + 32 * (wc & 1) + 8 * fq);
#pragma unroll
                    for (int bj = 0; bj < 2; ++bj) {
                        f32x4 v0 = acc[ai][bj][m][0] * sc, v1 = acc[ai][bj][m][1] * sc;
                        if (dorope) {
                            f32x4 r0, r1;
                            r0[0] = v0[0] * cs0[0] - v0[1] * cs0[1]; r0[1] = v0[0] * cs0[1] + v0[1] * cs0[0];
                            r0[2] = v0[2] * cs0[2] - v0[3] * cs0[3]; r0[3] = v0[2] * cs0[3] + v0[3] * cs0[2];
                            r1[0] = v1[0] * cs1[0] - v1[1] * cs1[1]; r1[1] = v1[0] * cs1[1] + v1[1] * cs1[0];
                            r1[2] = v1[2] * cs1[2] - v1[3] * cs1[3]; r1[3] = v1[2] * cs1[3] + v1[3] * cs1[2];
                            v0 = r0; v1 = r1; }
                        *(u32x4*)(rowp + (size_t)bj * 2 * MT * 64) = pack8(v0, v1); } } }
        } else {
#pragma unroll
            for (int ai = 0; ai < 2; ++ai)
#pragma unroll
                for (int m = 0; m < 4; ++m) {
                    const int pj = row0 + ai * 128 + m * 16, part = pj >> 9, j = pj & 511;
#pragma unroll
                    for (int bj = 0; bj < 2; ++bj) {
                        const int cc = col0 + bj * 128; bf16* dst;
                        if (u.pn < 16) { const int b = u.pn, t = cc - 256 * b; dst = ZTC + ((size_t)(b * 512 + j) * 512 + part * 256 + t); }
                        else { const int tok = cc - NCTX, b = tok >> 12, t = tok & 4095; dst = ZT + ((size_t)(b * 512 + j) * 8192 + part * 4096 + t); }
                        *(u32x4*)dst = pack8(acc[ai][bj][m][0], acc[ai][bj][m][1]); } }
        }
    }
};
struct EpiCat {
    static constexpr bool PERM = true;
    bf16* CAT; int latent;
    __device__ __forceinline__ void operator()(AccRef acc, const Unit& u, int wr, int wc, int fr, int fq) const {
        const int rowbase = latent ? (NCTX + u.e * 4096) : (u.e * 256);
        const int row0 = rowbase + u.pm * 256 + wr * 64 + fr, col0 = u.pn * 256 + wc * 32 + 8 * fq;
#pragma unroll
        for (int ai = 0; ai < 2; ++ai)
#pragma unroll
            for (int m = 0; m < 4; ++m) { bf16* rowp = CAT + (size_t)(row0 + ai * 128 + m * 16) * 1024 + col0;
#pragma unroll
                for (int bj = 0; bj < 2; ++bj) *(u32x4*)(rowp + bj * 128) = pack8(acc[ai][bj][m][0], acc[ai][bj][m][1]); }
    }
};
struct EpiRes {
    static constexpr bool PERM = true;
    const float* xsrc; const float* csrc; bf16* XB; const float* modv; float* ss; int first;
    template <int AI, int MB, int NB, bool FIRST>
    __device__ __forceinline__ void batch(AccRef acc, const f32x4 (&gv)[2][2], const float* src, int row0, int col0, int fq, float& sqs) const {
        f32x4 xa[NB][2][FIRST ? 2 : 1];
#pragma unroll
        for (int q = 0; q < NB; ++q) { const size_t off = (size_t)(row0 + AI * 128 + (MB + q) * 16) * 1024 + col0;
#pragma unroll
            for (int bj = 0; bj < 2; ++bj) {
                if constexpr (FIRST) { xa[q][bj][0] = *(const f32x4*)(src + off + bj * 128); xa[q][bj][1] = *(const f32x4*)(src + off + bj * 128 + 4); }
                else xa[q][bj][0] = __builtin_bit_cast(f32x4, *(const u32x4*)(XB + off + bj * 128)); } }
#pragma unroll
        for (int q = 0; q < NB; ++q) { constexpr int dummy = 0; (void)dummy; const int m = MB + q; const size_t off = (size_t)(row0 + AI * 128 + m * 16) * 1024 + col0; float sq = 0.f;
#pragma unroll
            for (int bj = 0; bj < 2; ++bj) { f32x4 x0, x1;
                if constexpr (FIRST) { x0 = xa[q][bj][0]; x1 = xa[q][bj][1]; }
                else { const u32x4 w = __builtin_bit_cast(u32x4, xa[q][bj][0]); x0 = (f32x4){bf_lo(w.x), bf_hi(w.x), bf_lo(w.y), bf_hi(w.y)}; x1 = (f32x4){bf_lo(w.z), bf_hi(w.z), bf_lo(w.w), bf_hi(w.w)}; }
                const f32x4 o0 = x0 + gv[bj][0] * acc[AI][bj][m][0], o1 = x1 + gv[bj][1] * acc[AI][bj][m][1];
                *(u32x4*)(XB + off + bj * 128) = pack8(o0, o1);
                sq += ((o0[0] * o0[0] + o0[1] * o0[1]) + (o0[2] * o0[2] + o0[3] * o0[3])) + ((o1[0] * o1[0] + o1[1] * o1[1]) + (o1[2] * o1[2] + o1[3] * o1[3])); }
            { auto s1 = __builtin_amdgcn_permlane16_swap(__float_as_uint(sq), __float_as_uint(sq), false, false); sq = __uint_as_float(s1[0]) + __uint_as_float(s1[1]);
              auto s2 = __builtin_amdgcn_permlane32_swap(__float_as_uint(sq), __float_as_uint(sq), false, false); sq = __uint_as_float(s2[0]) + __uint_as_float(s2[1]); }
            sqs = (fq == m) ? sq : sqs; }
    }
    __device__ __forceinline__ void operator()(AccRef acc, const Unit& u, int wr, int wc, int fr, int fq) const {
        const int row0 = u.pm * 256 + wr * 64 + fr, col0 = u.pn * 256 + wc * 32 + 8 * fq;
        const bool isctx = u.pm < 16; const int b = isctx ? 16 : ((u.pm - 16) >> 4);
        const float* src = isctx ? csrc : xsrc - (size_t)NCTX * 1024;
        f32x4 gv[2][2];
#pragma unroll
        for (int bj = 0; bj < 2; ++bj)
#pragma unroll
            for (int n = 0; n < 2; ++n) gv[bj][n] = *(const f32x4*)(modv + b * 6144 + 2048 + col0 + bj * 128 + n * 4);
        float sq0 = 0.f, sq1 = 0.f;
        if (first) { batch<0, 0, 2, true>(acc, gv, src, row0, col0, fq, sq0); batch<0, 2, 2, true>(acc, gv, src, row0, col0, fq, sq0); }
        else batch<0, 0, 4, false>(acc, gv, src, row0, col0, fq, sq0);
        ss[(size_t)(row0 + fq * 16) * 16 + u.pn * 4 + wc] = sq0;
        if (first) batch<1, 0, 4, true>(acc, gv, src, row0, col0, fq, sq1); else batch<1, 0, 4, false>(acc, gv, src, row0, col0, fq, sq1);
        ss[(size_t)(row0 + 128 + fq * 16) * 16 + u.pn * 4 + wc] = sq1;
    }
};
struct EpiW1 {
    static constexpr bool PERM = true;
    bf16* ACT; const float* b1;
    __device__ __forceinline__ void operator()(AccRef acc, const Unit& u, int wr, int wc, int fr, int fq) const {
        const int row0 = u.pm * 256 + wr * 64 + fr, a0 = u.pn * 128 + wc * 32 + 8 * fq;
        const f32x4* bp = (const f32x4*)(b1 + u.e * 2048 + 2 * a0);
        const f32x4 q0 = bp[0], q1 = bp[1], q2 = bp[2], q3 = bp[3];
        const f32x4 bg0 = (f32x4){q0[0], q0[2], q1[0], q1[2]}, bl0 = (f32x4){q0[1], q0[3], q1[1], q1[3]};
        const f32x4 bg1 = (f32x4){q2[0], q2[2], q3[0], q3[2]}, bl1 = (f32x4){q2[1], q2[3], q3[1], q3[3]};
#pragma unroll
        for (int ai = 0; ai < 2; ++ai)
#pragma unroll
            for (int m = 0; m < 4; ++m) {
                f32x4 o[2];
#pragma unroll
                for (int n = 0; n < 2; ++n) {
                    const f32x4 g = acc[ai][0][m][n] + (n ? bg1 : bg0), lv = acc[ai][1][m][n] + (n ? bl1 : bl0);
#pragma unroll
                    for (int j = 0; j < 4; ++j) { const float xg = fminf(g[j], 7.0f), xl = fminf(fmaxf(lv[j], -7.0f), 7.0f);
                        const float sg = __builtin_amdgcn_rcpf(1.0f + __builtin_amdgcn_exp2f(-1.702f * 1.4426950408889634f * xg)); o[n][j] = xg * sg * (xl + 1.0f); } }
                *(u32x4*)(ACT + (size_t)(row0 + ai * 128 + m * 16) * 1024 + a0) = pack8(o[0], o[1]); }
    }
};
__device__ __forceinline__ u32x4 widen_pair(u32x2 a, u32x2 b) {
    const auto rx = __builtin_amdgcn_permlane16_swap(a.x, b.x, false, false); const auto ry = __builtin_amdgcn_permlane16_swap(a.y, b.y, false, false);
    u32x4 o; o.x = rx[0]; o.y = ry[0]; o.z = rx[1]; o.w = ry[1]; return o; }
struct EpiW1Q {
    static constexpr bool PERM = true;
    unsigned char* ACT8; const float* b1; const float* cs; float hinv;
    __device__ __forceinline__ const float* sideA(const Unit& u) const { return b1 + u.e * 2048 + u.pn * 256; }
    __device__ __forceinline__ const float* sideB(const Unit& u) const { return cs + u.e * 2048 + u.pn * 256; }
    __device__ __forceinline__ void operator()(AccRef acc, const Unit& u, int wr, int wc, int fr, int fq, const LAS float* side) const {
        const int row0 = u.pm * 256 + wr * 64 + fr, aw = u.pn * 128 + wc * 32 + 16 * (fq >> 1);
        const LAS f32x4* bp = (const LAS f32x4*)(side + 64 * wc + 16 * fq);
        const f32x4 q0 = bp[0], q1 = bp[1], q2 = bp[2], q3 = bp[3];
        const f32x4 bg0 = (f32x4){q0[0], q0[2], q1[0], q1[2]}, bl0 = (f32x4){q0[1], q0[3], q1[1], q1[3]};
        const f32x4 bg1 = (f32x4){q2[0], q2[2], q3[0], q3[2]}, bl1 = (f32x4){q2[1], q2[3], q3[1], q3[3]};
        const float hi = hinv;
        const LAS float* cp = side + 256 + wc * 32 + 8 * fq;
        const f32x4 sg0 = *(const LAS f32x4*)cp * hi, sg1 = *(const LAS f32x4*)(cp + 4) * hi, sl0 = *(const LAS f32x4*)(cp + 128) * hi, sl1 = *(const LAS f32x4*)(cp + 132) * hi;
#pragma unroll
        for (int ai = 0; ai < 2; ++ai) {
            u32x2 w[4];
#pragma unroll
            for (int m = 0; m < 4; ++m) {
                float o[8];
#pragma unroll
                for (int n = 0; n < 2; ++n) {
                    const f32x4 g = acc[ai][0][m][n] * (n ? sg1 : sg0) + (n ? bg1 : bg0), lv = acc[ai][1][m][n] * (n ? sl1 : sl0) + (n ? bl1 : bl0);
#pragma unroll
                    for (int j = 0; j < 4; ++j) { const float xg = fminf(g[j], 7.0f), xl = fminf(fmaxf(lv[j], -7.0f), 7.0f);
                        const float sg = __builtin_amdgcn_rcpf(1.0f + __builtin_amdgcn_exp2f(-1.702f * 1.4426950408889634f * xg)); o[4 * n + j] = (xg * sg) * __builtin_fmaf(xl, 4.0f, 4.0f); } }
                w[m].x = cvt4_fp8(o[0], o[1], o[2], o[3]); w[m].y = cvt4_fp8(o[4], o[5], o[6], o[7]); }
#pragma unroll
            for (int pr = 0; pr < 2; ++pr)
                *(u32x4*)(ACT8 + (size_t)(row0 + ai * 128 + (2 * pr + (fq & 1)) * 16) * 1024 + aw) = widen_pair(w[2 * pr], w[2 * pr + 1]); }
    }
};
struct EpiW2Q {
    static constexpr bool PERM = true;
    unsigned char* EOUT8; unsigned char* ES; const float* b2; const float* cs;
    __device__ __forceinline__ const float* sideA(const Unit& u) const { return b2 + u.e * 1024 + u.pn * 256; }
    __device__ __forceinline__ const float* sideB(const Unit& u) const { return cs + u.e * 1024 + u.pn * 256; }
    __device__ __forceinline__ void operator()(AccRef acc, const Unit& u, int wr, int wc, int fr, int fq, const LAS float* side) const {
        const int row0 = u.pm * 256 + wr * 64 + fr, cw = u.pn * 256 + wc * 32 + 16 * (fq >> 1), lc = wc * 32 + 8 * fq;
        f32x4 bv[2][2], sv[2][2];
#pragma unroll
        for (int bj = 0; bj < 2; ++bj)
#pragma unroll
            for (int n = 0; n < 2; ++n) { bv[bj][n] = *(const LAS f32x4*)(side + lc + bj * 128 + 4 * n); sv[bj][n] = *(const LAS f32x4*)(side + 256 + lc + bj * 128 + 4 * n) * 0.25f; }
#pragma unroll
        for (int ai = 0; ai < 2; ++ai) { unsigned sbw = 0u;
#pragma unroll
            for (int bj = 0; bj < 2; ++bj) { u32x2 w[4];
#pragma unroll
                for (int m = 0; m < 4; ++m) {
                    const f32x4 v0 = acc[ai][bj][m][0] * sv[bj][0] + bv[bj][0], v1 = acc[ai][bj][m][1] * sv[bj][1] + bv[bj][1];
                    float amax = fmaxf(fmaxf(fmaxf(fabsf(v0[0]), fabsf(v0[1])), fmaxf(fabsf(v0[2]), fabsf(v0[3]))), fmaxf(fmaxf(fabsf(v1[0]), fabsf(v1[1])), fmaxf(fabsf(v1[2]), fabsf(v1[3]))));
                    { auto s1 = __builtin_amdgcn_permlane16_swap(__float_as_uint(amax), __float_as_uint(amax), false, false); amax = fmaxf(__uint_as_float(s1[0]), __uint_as_float(s1[1]));
                      auto s2 = __builtin_amdgcn_permlane32_swap(__float_as_uint(amax), __float_as_uint(amax), false, false); amax = fmaxf(__uint_as_float(s2[0]), __uint_as_float(s2[1])); }
                    int sb; float inv; mx_scale(amax, sb, inv);
                    w[m].x = cvt4_fp8(v0[0] * inv, v0[1] * inv, v0[2] * inv, v0[3] * inv); w[m].y = cvt4_fp8(v1[0] * inv, v1[1] * inv, v1[2] * inv, v1[3] * inv);
                    sbw = (fq == m) ? (sbw | ((unsigned)sb << (8 * bj))) : sbw; }
#pragma unroll
                for (int pr = 0; pr < 2; ++pr)
                    *(u32x4*)(EOUT8 + (size_t)(row0 + ai * 128 + (2 * pr + (fq & 1)) * 16) * 1024 + cw + bj * 128) = widen_pair(w[2 * pr], w[2 * pr + 1]); }
            *(unsigned short*)(ES + (size_t)(row0 + ai * 128 + fq * 16) * 32 + u.pn * 8 + wc * 2) = (unsigned short)sbw; }
    }
};
struct EpiW2 {
    static constexpr bool PERM = true;
    bf16* EOUT; const float* b2;
    __device__ __forceinline__ void operator()(AccRef acc, const Unit& u, int wr, int wc, int fr, int fq) const {
        const int row0 = u.pm * 256 + wr * 64 + fr, col0 = u.pn * 256 + wc * 32 + 8 * fq;
        f32x4 bv[2][2];
#pragma unroll
        for (int bj = 0; bj < 2; ++bj)
#pragma unroll
            for (int n = 0; n < 2; ++n) bv[bj][n] = *(const f32x4*)(b2 + u.e * 1024 + col0 + bj * 128 + 4 * n);
#pragma unroll
        for (int ai = 0; ai < 2; ++ai)
#pragma unroll
            for (int m = 0; m < 4; ++m) { bf16* rowp = EOUT + (size_t)(row0 + ai * 128 + m * 16) * 1024 + col0;
#pragma unroll
                for (int bj = 0; bj < 2; ++bj) *(u32x4*)(rowp + bj * 128) = pack8(acc[ai][bj][m][0] + bv[bj][0], acc[ai][bj][m][1] + bv[bj][1]); }
    }
};

template <int KIND>
__device__ __forceinline__ void transpose_item(const float* src, int ld, int k0, int c0, bf16* dst, int Kdst, int drow0, LAS float* scr, int lane) {
#pragma unroll 32
    for (int kk = 0; kk < 64; ++kk) scr[kk * 65 + lane] = src[(size_t)(k0 + kk) * ld + c0 + lane];
    LDS_WAIT();
    const int c = lane & 7;
#pragma unroll
    for (int j = 0; j < 8; ++j) { const int n = (lane >> 3) + 8 * j; const LAS float* s = scr + (8 * c) * 65 + n;
        u32x4 o; o.x = cvt_pk_bf16(s[0 * 65], s[1 * 65]); o.y = cvt_pk_bf16(s[2 * 65], s[3 * 65]); o.z = cvt_pk_bf16(s[4 * 65], s[5 * 65]); o.w = cvt_pk_bf16(s[6 * 65], s[7 * 65]);
        int row;
        if (KIND == 0) row = drow0 + n;
        else if (KIND == 1) row = drow0 + (n < 32 ? 2 * n : 2 * (n - 32) + 1);
        else { const int cs = c0 + n, a = cs >> 1; row = 256 * (a >> 7) + 128 * (cs & 1) + (a & 127); }
        *(u32x4*)(dst + (size_t)row * Kdst + k0 + 8 * c) = o; }
    LDS_WAIT();
}

struct StripDesc { const float* src; int ld, c0; unsigned char* dq; float* dcs; int drow0, kind; };
__device__ __forceinline__ StripDesc strip_desc(const Args& a, unsigned char* ws, int it) {
    StripDesc d;
    if (it < 64 * 32) { const int le = it >> 5, nb = it & 31; d.src = a.in[I_W1] + (size_t)le * 1024 * 2048; d.ld = 2048; d.c0 = nb * 64; d.dq = ws + WS_W1Q + (size_t)le * 2048 * 1024; d.dcs = (float*)(ws + WS_W1CS) + (size_t)le * 2048; d.drow0 = 0; d.kind = 2; }
    else { const int r = it - 64 * 32, le = r >> 4, nb = r & 15; d.src = a.in[I_W2] + (size_t)le * 1024 * 1024; d.ld = 1024; d.c0 = nb * 64; d.dq = ws + WS_W2Q + (size_t)le * 1024 * 1024; d.dcs = (float*)(ws + WS_W2CS) + (size_t)le * 1024; d.drow0 = nb * 64; d.kind = 0; }
    return d;
}
__device__ __forceinline__ void strip_load(const StripDesc& d, int tid, f32x4 (&v)[32]) {
    const int lane = tid & 63, w = tid >> 6, kr = lane >> 4, cg = lane & 15;
#pragma unroll
    for (int i = 0; i < 32; ++i) v[i] = *(const f32x4*)(d.src + (size_t)(w * 128 + 4 * i + kr) * d.ld + d.c0 + 4 * cg);
}
__device__ __forceinline__ void strip_stage(const f32x4 (&v)[32], LAS unsigned char* lds, int tid) {
    LAS bf16* st = (LAS bf16*)lds; LAS float* red = (LAS float*)(lds + 1024 * 68 * 2);
    const int lane = tid & 63, w = tid >> 6, kr = lane >> 4, cg = lane & 15;
    f32x4 am = (f32x4){0.f, 0.f, 0.f, 0.f};
#pragma unroll
    for (int i = 0; i < 32; ++i) { const int k = w * 128 + 4 * i + kr;
        am[0] = fmaxf(am[0], fabsf(v[i][0])); am[1] = fmaxf(am[1], fabsf(v[i][1])); am[2] = fmaxf(am[2], fabsf(v[i][2])); am[3] = fmaxf(am[3], fabsf(v[i][3]));
        u32x2 pw; pw.x = cvt_pk_bf16(v[i][0], v[i][1]); pw.y = cvt_pk_bf16(v[i][2], v[i][3]); *(LAS u32x2*)(st + k * 68 + 4 * cg) = pw; }
#pragma unroll
    for (int e = 0; e < 4; ++e) { am[e] = fmaxf(am[e], __shfl_xor(am[e], 16)); am[e] = fmaxf(am[e], __shfl_xor(am[e], 32)); }
    if (kr == 0) *(LAS f32x4*)(red + w * 64 + 4 * cg) = am;
}
__device__ __forceinline__ void strip_quant(const StripDesc& d, LAS unsigned char* lds, int tid) {
    LAS bf16* st = (LAS bf16*)lds; LAS float* red = (LAS float*)(lds + 1024 * 68 * 2);
    const int n = tid >> 3, kq = tid & 7;
    float cm = 0.f;
#pragma unroll
    for (int i = 0; i < 8; ++i) cm = fmaxf(cm, red[i * 64 + n]);
    int sb; float inv; mx_scale(cm, sb, inv);
    int row;
    if (d.kind == 0) row = d.drow0 + n; else { const int cs_ = d.c0 + n, a = cs_ >> 1; row = 256 * (a >> 7) + 128 * (cs_ & 1) + (a & 127); }
#pragma unroll 2
    for (int i = 0; i < 8; ++i) { const int k0 = 128 * i + 16 * kq; float v[16];
#pragma unroll
        for (int e = 0; e < 16; ++e) v[e] = bf2f(st[(k0 + e) * 68 + n]) * inv;
        u32x4 o; o.x = cvt4_fp8(v[0], v[1], v[2], v[3]); o.y = cvt4_fp8(v[4], v[5], v[6], v[7]); o.z = cvt4_fp8(v[8], v[9], v[10], v[11]); o.w = cvt4_fp8(v[12], v[13], v[14], v[15]);
        *(u32x4*)(d.dq + (size_t)row * 1024 + k0) = o; }
    if (kq == 0) d.dcs[row] = __uint_as_float((unsigned)sb << 23);
}

__device__ __forceinline__ void p0_prologue(Frame& F, const Args& a) {
    const int gw = F.c * 8 + F.wave, NGW = F.G * 8, lane = F.lane;
    { LAS float* siluT = (LAS float*)F.lds;
      for (int i = F.tid; i < 17 * 1024; i += 512) { const int r = i >> 10, k = i & 1023; const float v = r < 16 ? a.in[I_C][r * 1024 + k] : a.in[I_CCTX][k]; siluT[i] = v / (1.0f + __expf(-v)); }
      __syncthreads();
      float* modp = (float*)(F.ws + WS_MODP);
      for (int it = gw; it < 192 * 16; it += NGW) {
          const int cg = it % 192, ks = it / 192, col = cg * 64 + lane, l = col / 6144, cc = col - l * 6144;
          const float* wp = a.in[I_MODW] + ((size_t)l * 1024 + ks * 64) * 6144 + cc;
          float wv[64];
#pragma unroll
          for (int k = 0; k < 64; ++k) wv[k] = wp[(size_t)k * 6144];
          float acc[17];
#pragma unroll
          for (int r = 0; r < 17; ++r) acc[r] = 0.f;
#pragma unroll
          for (int k = 0; k < 64; ++k) {
#pragma unroll
              for (int r = 0; r < 17; ++r) acc[r] += siluT[r * 1024 + ks * 64 + k] * wv[k]; }
#pragma unroll
          for (int r = 0; r < 17; ++r) modp[(size_t)(ks * 17 + r) * 12288 + col] = acc[r];
      }
      __syncthreads(); }
    SUBSTAMP(F, 0, 5);
    { LAS f32x2* tab = (LAS f32x2*)F.lds;
      for (int i = F.tid; i < 4096; i += 512) { float s, c; sincospif((float)i * (1.0f / 2048.0f), &s, &c); tab[i] = (f32x2){c, s}; }
      __syncthreads();
      bf16* dftc = (bf16*)(F.ws + WS_DFTC);
      for (int it = gw; it < 256; it += NGW) {
          { const int tp = it, k8 = lane * 8; float v[8];
#pragma unroll
              for (int e = 0; e < 8; ++e) { const int kk = k8 + e, part = kk >> 8, t = kk & 255; const f32x2 cs = tab[((t * tp) & 255) * 16]; v[e] = (part ? -cs.y : cs.x) * (1.0f / 16.0f); }
              u32x4 o; o.x = cvt_pk_bf16(v[0], v[1]); o.y = cvt_pk_bf16(v[2], v[3]); o.z = cvt_pk_bf16(v[4], v[5]); o.w = cvt_pk_bf16(v[6], v[7]);
              *(u32x4*)(dftc + (size_t)tp * 512 + k8) = o; } }
      bf16* wf = (bf16*)(F.ws + WS_WF);
      for (int it = gw; it < 2 * 8 * 128; it += NGW) {
          const int l = it >> 10, g = (it >> 7) & 7, k8 = it & 127;
          float xin[8], ac[8], as[8];
#pragma unroll
          for (int kk = 0; kk < 8; ++kk) { xin[kk] = a.in[I_WIN][((size_t)l * 1024 + k8 * 8 + kk) * 2560 + g * 64 + lane]; ac[kk] = 0.f; as[kk] = 0.f; }
          for (int cidx = 0; cidx < 64; ++cidx) { const f32x2 cs = tab[((cidx * lane) & 63) * 64];
#pragma unroll
              for (int kk = 0; kk < 8; ++kk) { const float v = __shfl(xin[kk], cidx); ac[kk] += v * cs.x; as[kk] += v * cs.y; } }
          u32x4 oc, os;
          oc.x = cvt_pk_bf16(ac[0] * 0.125f, ac[1] * 0.125f); oc.y = cvt_pk_bf16(ac[2] * 0.125f, ac[3] * 0.125f); oc.z = cvt_pk_bf16(ac[4] * 0.125f, ac[5] * 0.125f); oc.w = cvt_pk_bf16(ac[6] * 0.125f, ac[7] * 0.125f);
          os.x = cvt_pk_bf16(as[0] * 0.125f, as[1] * 0.125f); os.y = cvt_pk_bf16(as[2] * 0.125f, as[3] * 0.125f); os.z = cvt_pk_bf16(as[4] * 0.125f, as[5] * 0.125f); os.w = cvt_pk_bf16(as[6] * 0.125f, as[7] * 0.125f);
          *(u32x4*)(wf + ((size_t)l * 1024 + g * 64 + lane) * 1024 + k8 * 8) = oc;
          *(u32x4*)(wf + ((size_t)l * 1024 + 512 + g * 64 + lane) * 1024 + k8 * 8) = os; }
      if (F.c == 0) { float* rope = (float*)(F.ws + WS_ROPE);
          for (int i = F.tid; i < 64 * 16; i += 512) { const int pos = i >> 4, f = i & 15; const float fr = powf(10000.0f, -(float)f / 16.0f); const float ang = (float)pos * fr; rope[i * 2] = cosf(ang); rope[i * 2 + 1] = sinf(ang); } }
      __syncthreads(); }
    SUBSTAMP(F, 0, 6);
    { LAS float* scr = (LAS float*)(F.lds + F.wave * 16640);
      constexpr int N_IN = 2 * 16 * 32, N_OUT = 2 * 16 * 16, NITEMS = N_IN + N_OUT;
      for (int it = gw; it < NITEMS; it += NGW) {
          int r = it;
          if (r < N_IN) { const int l = r >> 9, kb = (r >> 5) & 15, nb = r & 31; const float* src = a.in[I_WIN] + (size_t)l * 1024 * 2560; bf16* dst = (bf16*)(F.ws + WS_WQ) + (size_t)l * 2048 * 1024;
              if (nb < 16) transpose_item<1>(src, 2560, kb * 64, 512 + nb * 64, dst, 1024, nb * 64, scr, lane);
              else transpose_item<0>(src, 2560, kb * 64, 512 + nb * 64, dst, 1024, nb * 64, scr, lane);
              continue; }
          r -= N_IN;
          { const int l = r >> 8, kb = (r >> 4) & 15, nb = r & 15;
            transpose_item<0>(a.in[I_WOUT] + (size_t)l * 1024 * 1024, 1024, kb * 64, nb * 64, (bf16*)(F.ws + WS_WO) + (size_t)l * 1024 * 1024, 1024, nb * 64, scr, lane); }
      } }
    __syncthreads();
    SUBSTAMP(F, 0, 7);
    { constexpr int NSTRIP = 64 * 32 + 64 * 16; int it = F.c; f32x4 sv[32];
      if (it < NSTRIP) { const StripDesc d = strip_desc(a, F.ws, it); strip_load(d, F.tid, sv); }
      while (it < NSTRIP) {
          strip_stage(sv, F.lds, F.tid);
          __syncthreads();
          const int itn = it + F.G;
          if (itn < NSTRIP) { const StripDesc dn = strip_desc(a, F.ws, itn); strip_load(dn, F.tid, sv); }
          { const StripDesc d = strip_desc(a, F.ws, it); strip_quant(d, F.lds, F.tid); }
          __syncthreads();
          it = itn; } }
}

__device__ __forceinline__ float mod_sum(const float* modp, const float* modb, int l, int r, int cc) {
    float s = modb[l * 6144 + cc];
#pragma unroll
    for (int ks = 0; ks < 16; ++ks) s += modp[(size_t)(ks * 17 + r) * 12288 + l * 6144 + cc];
    return s;
}
__device__ __forceinline__ void p0b_finalize(Frame& F, const Args& a) {
    const float* modp = (const float*)(F.ws + WS_MODP); float* modv = (float*)(F.ws + WS_MODV); float* a12 = (float*)(F.ws + WS_A12);
    const int gt = F.c * 512 + F.tid, NT = F.G * 512;
    for (int i = gt; i < 2 * 17 * 6144; i += NT) { const int l = i / (17 * 6144), rem = i - l * 17 * 6144, r = rem / 6144, cc = rem - r * 6144; modv[i] = mod_sum(modp, a.in[I_MODB], l, r, cc); }
    for (int i = gt; i < 2 * 2 * 17 * 1024; i += NT) { const int k = i & 1023, r = (i >> 10) % 17, w = ((i >> 10) / 17) & 1, l = (i >> 10) / 34;
        a12[i] = a.in[I_NORMW][(l * 2 + w) * 1024 + k] * (1.0f + mod_sum(modp, a.in[I_MODB], l, r, (w ? 4096 : 1024) + k)); }
}

__device__ __forceinline__ void p1_router_tables(Frame& F, const Args& a) {
    const int gt = F.c * 512 + F.tid, NT = F.G * 512;
    for (int i = gt; i < 2 * 32 * 2 * 64; i += NT) { const int ln = i & 63, et = (i >> 6) & 1, ks = (i >> 7) & 31, l = i >> 12; float hi[8], lo[8];
        const float* rwp = a.in[I_RW] + (size_t)l * 1024 * 32;
#pragma unroll
        for (int e = 0; e < 8; ++e) { const float wv = rwp[(size_t)(32 * ks + 8 * (ln >> 4) + e) * 32 + 16 * et + (ln & 15)]; const unsigned hb = cvt_pk_bf16(wv, 0.f) & 0xffffu; hi[e] = __uint_as_float(hb << 16); lo[e] = wv - hi[e]; }
        u32x4 wh, wl; wh.x = cvt_pk_bf16(hi[0], hi[1]); wh.y = cvt_pk_bf16(hi[2], hi[3]); wh.z = cvt_pk_bf16(hi[4], hi[5]); wh.w = cvt_pk_bf16(hi[6], hi[7]);
        wl.x = cvt_pk_bf16(lo[0], lo[1]); wl.y = cvt_pk_bf16(lo[2], lo[3]); wl.z = cvt_pk_bf16(lo[4], lo[5]); wl.w = cvt_pk_bf16(lo[6], lo[7]);
        unsigned char* rt = F.ws + WS_RT + (size_t)l * 131072;
        *(u32x4*)(rt + ((ks * 2 + et) * 2 + 0) * 1024 + ln * 16) = wh; *(u32x4*)(rt + ((ks * 2 + et) * 2 + 1) * 1024 + ln * 16) = wl; }
    if (F.c < 2) { const int l = F.c;
        const float* a12l = (const float*)(F.ws + WS_A12) + (size_t)(l * 2 + 1) * 17 * 1024; const float* modl = (const float*)(F.ws + WS_MODV) + (size_t)l * 17 * 6144;
        float gm = 0.f, sm = 0.f;
        for (int i = F.tid; i < 17 * 1024; i += 512) { gm = fmaxf(gm, fabsf(a12l[i])); sm = fmaxf(sm, fabsf(modl[(size_t)(i >> 10) * 6144 + 3072 + (i & 1023)])); }
#pragma unroll
        for (int o = 1; o < 64; o <<= 1) { gm = fmaxf(gm, __shfl_xor(gm, o)); sm = fmaxf(sm, __shfl_xor(sm, o)); }
        LAS float* rd = (LAS float*)F.lds;
        if (F.lane == 0) { rd[F.wave * 2] = gm; rd[F.wave * 2 + 1] = sm; }
        __syncthreads();
        if (F.tid == 0) { gm = 0.f; sm = 0.f; for (int i = 0; i < 8; ++i) { gm = fmaxf(gm, rd[2 * i]); sm = fmaxf(sm, rd[2 * i + 1]); }
            int sb; float inv; mx_scale(32.0f * gm + sm, sb, inv); float* hs = (float*)(F.ws + WS_HSC) + l * 2; hs[0] = inv; hs[1] = __uint_as_float((unsigned)sb << 23); }
        __syncthreads(); }
}
__device__ __forceinline__ void p1_norm1_layer0(Frame& F, const Args& a) {
    const int gw = F.c * 8 + F.wave, NGW = F.G * 8, lane = F.lane; constexpr int NR = 4;
    const float* a12 = (const float*)(F.ws + WS_A12); const float* modv = (const float*)(F.ws + WS_MODV); bf16* H = (bf16*)(F.ws + WS_H);
    for (int r0 = gw * NR; r0 < MT; r0 += NGW * NR) {
        const int b = batch_of_row(r0);
        f32x4 v[NR][4], g[4], sh[4];
#pragma unroll
        for (int q = 0; q < NR; ++q) { const int r = r0 + q; const float* xrow = r < NCTX ? a.in[I_CTX] + (size_t)r * 1024 : a.in[I_X] + (size_t)(r - NCTX) * 1024;
#pragma unroll
            for (int j = 0; j < 4; ++j) v[q][j] = ((const f32x4*)xrow)[lane + 64 * j]; }
#pragma unroll
        for (int j = 0; j < 4; ++j) { g[j] = ((const f32x4*)(a12 + (size_t)b * 1024))[lane + 64 * j]; sh[j] = ((const f32x4*)(modv + (size_t)b * 6144))[lane + 64 * j]; }
#pragma unroll
        for (int q = 0; q < NR; ++q) { float ss = 0.f;
#pragma unroll
            for (int j = 0; j < 4; ++j) ss += (v[q][j][0] * v[q][j][0] + v[q][j][1] * v[q][j][1]) + (v[q][j][2] * v[q][j][2] + v[q][j][3] * v[q][j][3]);
            const float rn = rsqrtf(wave_sum(ss) * (1.0f / 1024.0f) + NORM_EPS);
#pragma unroll
            for (int j = 0; j < 4; ++j) { const f32x4 h = v[q][j] * rn * g[j] + sh[j]; u32x2 w; w.x = cvt_pk_bf16(h[0], h[1]); w.y = cvt_pk_bf16(h[2], h[3]); ((u32x2*)(H + (size_t)(r0 + q) * 1024))[lane + 64 * j] = w; } }
    }
}

typedef short v4i16_t __attribute__((ext_vector_type(4)));
__device__ __forceinline__ bf16x8 tr8(const LAS bf16* p, int rs4) {
    const v4i16_t lo = __builtin_amdgcn_ds_read_tr16_b64_v4i16((LAS v4i16_t*)p), hi = __builtin_amdgcn_ds_read_tr16_b64_v4i16((LAS v4i16_t*)(p + rs4));
    return (bf16x8){lo[0], lo[1], lo[2], lo[3], hi[0], hi[1], hi[2], hi[3]};
}
__device__ __forceinline__ void retention_phase(Frame& F, const Args& a, int l) {
    constexpr int QS = 72, TS = 136, SS = 72;
    constexpr int O_Q = 0, O_K = 18432, O_KW = 36864, O_V = 55296, O_P = 73728, O_ST = 108544;
    LAS bf16* Qs = (LAS bf16*)(F.lds + O_Q); LAS bf16* Ks = (LAS bf16*)(F.lds + O_K); LAS bf16* Kw = (LAS bf16*)(F.lds + O_KW); LAS bf16* Vs = (LAS bf16*)(F.lds + O_V);
    LAS bf16* Ps = (LAS bf16*)(F.lds + O_P); LAS bf16* ST = (LAS bf16*)(F.lds + O_ST);
    const bf16* QKVG = (const bf16*)(F.ws + WS_QKVG);
    const int tid = F.tid, lane = F.lane, w = F.wave, lr = lane & 15, lq = lane >> 4;
    const int troff = (8 * lq + (lr >> 2)) * QS + 4 * (lr & 3);
    for (int unit = F.c; unit < 256; unit += F.G) {
        const int dir = unit & 1, h = (unit >> 1) & 7, b = unit >> 4;
        bf16* OUT = (bf16*)(F.ws + (dir ? WS_OB : WS_OF));
        const float rd = a.in[I_DECAY][l * 16 + dir * 8 + h];
        const float lg2 = log1pf(-exp2f(-rd)) * 1.4426950408889634f;
        const int il = 16 * w + lr;
        float mask[8][4];
#pragma unroll
        for (int jt = 0; jt < 8; ++jt)
#pragma unroll
            for (int r = 0; r < 4; ++r) { const int j = 16 * jt + 4 * lq + r; mask[jt][r] = (j <= il) ? exp2f((float)(il - j) * lg2) : 0.0f; }
        const float wq = exp2f((float)(il + 1) * lg2), gch = exp2f(128.0f * lg2);
        const int ldr = tid >> 2, ldq = tid & 3;
        const float wkv = exp2f((float)(127 - ldr) * lg2);
        f32x4 Sacc[2] = {(f32x4){0.f, 0.f, 0.f, 0.f}, (f32x4){0.f, 0.f, 0.f, 0.f}};
        const int tm = w >> 1, tn0 = 2 * (w & 1);
        for (int i = tid; i < 64 * SS / 2; i += 512) ((LAS unsigned*)ST)[i] = 0u;
        u32x4 pq[2], pk[2], pv[2];
        auto chunk_base = [&](int s) -> int { if (s < 2) return b * 256 + 128 * (dir ? 1 - s : s); return NCTX + b * 4096 + 128 * (dir ? 31 - (s - 2) : (s - 2)); };
        { const int gr = chunk_base(0) + (dir ? 127 - ldr : ldr); const bf16* p = QKVG + ((size_t)h * MT + gr) * 64 + ldq * 16; constexpr size_t TSTR = (size_t)8 * MT * 64;
          pq[0] = *(const u32x4*)p; pq[1] = *(const u32x4*)(p + 8); pk[0] = *(const u32x4*)(p + TSTR); pk[1] = *(const u32x4*)(p + TSTR + 8); pv[0] = *(const u32x4*)(p + 2 * TSTR); pv[1] = *(const u32x4*)(p + 2 * TSTR + 8); }
        for (int s = 0; s < 34; ++s) {
            const int cb = chunk_base(s);
            { const int o = ldr * QS + ldq * 16;
              *(LAS u32x4*)(Qs + o) = pq[0]; *(LAS u32x4*)(Qs + o + 8) = pq[1]; *(LAS u32x4*)(Ks + o) = pk[0]; *(LAS u32x4*)(Ks + o + 8) = pk[1]; *(LAS u32x4*)(Vs + o) = pv[0]; *(LAS u32x4*)(Vs + o + 8) = pv[1];
              u32x4 kw0, kw1;
              kw0.x = cvt_pk_bf16(bf_lo(pk[0].x) * wkv, bf_hi(pk[0].x) * wkv); kw0.y = cvt_pk_bf16(bf_lo(pk[0].y) * wkv, bf_hi(pk[0].y) * wkv); kw0.z = cvt_pk_bf16(bf_lo(pk[0].z) * wkv, bf_hi(pk[0].z) * wkv); kw0.w = cvt_pk_bf16(bf_lo(pk[0].w) * wkv, bf_hi(pk[0].w) * wkv);
              kw1.x = cvt_pk_bf16(bf_lo(pk[1].x) * wkv, bf_hi(pk[1].x) * wkv); kw1.y = cvt_pk_bf16(bf_lo(pk[1].y) * wkv, bf_hi(pk[1].y) * wkv); kw1.z = cvt_pk_bf16(bf_lo(pk[1].z) * wkv, bf_hi(pk[1].z) * wkv); kw1.w = cvt_pk_bf16(bf_lo(pk[1].w) * wkv, bf_hi(pk[1].w) * wkv);
              *(LAS u32x4*)(Kw + o) = kw0; *(LAS u32x4*)(Kw + o + 8) = kw1; }
            __syncthreads();
            if (s + 1 < 34) { const int gr = chunk_base(s + 1) + (dir ? 127 - ldr : ldr); const bf16* p = QKVG + ((size_t)h * MT + gr) * 64 + ldq * 16; constexpr size_t TSTR = (size_t)8 * MT * 64;
                pq[0] = *(const u32x4*)p; pq[1] = *(const u32x4*)(p + 8); pk[0] = *(const u32x4*)(p + TSTR); pk[1] = *(const u32x4*)(p + TSTR + 8); pv[0] = *(const u32x4*)(p + 2 * TSTR); pv[1] = *(const u32x4*)(p + 2 * TSTR + 8); }
            bf16x8 bq[2];
#pragma unroll
            for (int ks = 0; ks < 2; ++ks) bq[ks] = *(const LAS bf16x8*)(Qs + (16 * w + lr) * QS + 32 * ks + 8 * lq);
#pragma unroll
            for (int jt = 0; jt < 8; ++jt) {
                if (jt <= w) {
                    f32x4 p = (f32x4){0.f, 0.f, 0.f, 0.f};
#pragma unroll
                    for (int ks = 0; ks < 2; ++ks) { const bf16x8 ak = *(const LAS bf16x8*)(Ks + (16 * jt + lr) * QS + 32 * ks + 8 * lq); p = __builtin_amdgcn_mfma_f32_16x16x32_bf16(ak, bq[ks], p, 0, 0, 0); }
                    u32x2 pw; pw.x = cvt_pk_bf16(p[0] * mask[jt][0], p[1] * mask[jt][1]); pw.y = cvt_pk_bf16(p[2] * mask[jt][2], p[3] * mask[jt][3]);
                    *(LAS u32x2*)(Ps + (16 * w + lr) * TS + 16 * jt + 4 * lq) = pw;
                } else if (jt == w + 1) { u32x2 pz; pz.x = 0u; pz.y = 0u; *(LAS u32x2*)(Ps + (16 * w + lr) * TS + 16 * jt + 4 * lq) = pz; } }
            LDS_WAIT();
            f32x4 oacc[4], cacc[4];
#pragma unroll
            for (int tn = 0; tn < 4; ++tn) { oacc[tn] = (f32x4){0.f, 0.f, 0.f, 0.f}; cacc[tn] = (f32x4){0.f, 0.f, 0.f, 0.f}; }
#pragma unroll
            for (int ks = 0; ks < 4; ++ks) if (2 * ks <= w) { const bf16x8 bp = *(const LAS bf16x8*)(Ps + (16 * w + lr) * TS + 32 * ks + 8 * lq);
#pragma unroll
                for (int tn = 0; tn < 4; ++tn) { const bf16x8 av = tr8(Vs + troff + 32 * ks * QS + 16 * tn, 4 * QS); oacc[tn] = __builtin_amdgcn_mfma_f32_16x16x32_bf16(av, bp, oacc[tn], 0, 0, 0); } }
#pragma unroll
            for (int ks = 0; ks < 2; ++ks)
#pragma unroll
                for (int tn = 0; tn < 4; ++tn) { const bf16x8 as_ = *(const LAS bf16x8*)(ST + (16 * tn + lr) * SS + 32 * ks + 8 * lq); cacc[tn] = __builtin_amdgcn_mfma_f32_16x16x32_bf16(as_, bq[ks], cacc[tn], 0, 0, 0); }
            { const int gr = cb + (dir ? 127 - il : il); bf16* op = OUT + ((size_t)h * MT + gr) * 64 + 4 * lq;
#pragma unroll
              for (int tn = 0; tn < 4; ++tn) { const f32x4 o = oacc[tn] + cacc[tn] * wq; u32x2 ow; ow.x = cvt_pk_bf16(o[0], o[1]); ow.y = cvt_pk_bf16(o[2], o[3]); *(u32x2*)(op + 16 * tn) = ow; } }
            f32x4 sn[2] = {(f32x4){0.f, 0.f, 0.f, 0.f}, (f32x4){0.f, 0.f, 0.f, 0.f}};
#pragma unroll
            for (int ks = 0; ks < 4; ++ks) { const bf16x8 ak = tr8(Kw + troff + 32 * ks * QS + 16 * tm, 4 * QS);
#pragma unroll
                for (int q = 0; q < 2; ++q) { const bf16x8 bv = tr8(Vs + troff + 32 * ks * QS + 16 * (tn0 + q), 4 * QS); sn[q] = __builtin_amdgcn_mfma_f32_16x16x32_bf16(ak, bv, sn[q], 0, 0, 0); } }
#pragma unroll
            for (int q = 0; q < 2; ++q) Sacc[q] = Sacc[q] * gch + sn[q];
            __syncthreads();
#pragma unroll
            for (int q = 0; q < 2; ++q) { u32x2 sw; sw.x = cvt_pk_bf16(Sacc[q][0], Sacc[q][1]); sw.y = cvt_pk_bf16(Sacc[q][2], Sacc[q][3]); *(LAS u32x2*)(ST + (16 * (tn0 + q) + lr) * SS + 16 * tm + 4 * lq) = sw; }
        }
        __syncthreads();
    }
}

__device__ __forceinline__ void merge_phase(Frame& F, const Args& a, int l) {
    const bool skew = (l == 0 && F.G == 256); if (skew && F.c < 32) return;
    const int gw = (skew ? F.c - 32 : F.c) * 8 + F.wave, NGW = (skew ? F.G - 32 : F.G) * 8, lane = F.lane; constexpr int NR = 4;
    const bf16* OFp = (const bf16*)(F.ws + WS_OF); const bf16* OBp = (const bf16*)(F.ws + WS_OB); const bf16* QKVG = (const bf16*)(F.ws + WS_QKVG); bf16* CAT = (bf16*)(F.ws + WS_CAT);
    const float* rw = a.in[I_RNW] + l * 512 + lane * 8;
    const f32x4 w0 = *(const f32x4*)rw, w1 = *(const f32x4*)(rw + 4);
    for (int r0 = (l ? NCTX : 0) + gw * NR; r0 < MT; r0 += NGW * NR) {
        u32x4 fv[NR], bv[NR], gv[NR];
#pragma unroll
        for (int q = 0; q < NR; ++q) { const size_t r = r0 + q, ho = ((size_t)(lane >> 3) * MT + r) * 64 + 8 * (lane & 7); fv[q] = *(const u32x4*)(OFp + ho); bv[q] = *(const u32x4*)(OBp + ho); gv[q] = *(const u32x4*)(QKVG + (size_t)24 * MT * 64 + ho); }
#pragma unroll
        for (int q = 0; q < NR; ++q) {
            float o[8]; const unsigned fw[4] = {fv[q].x, fv[q].y, fv[q].z, fv[q].w}, bw[4] = {bv[q].x, bv[q].y, bv[q].z, bv[q].w}, gwd[4] = {gv[q].x, gv[q].y, gv[q].z, gv[q].w};
            float sm = 0.f;
#pragma unroll
            for (int e = 0; e < 4; ++e) { o[2 * e] = bf_lo(fw[e]) + bf_lo(bw[e]); o[2 * e + 1] = bf_hi(fw[e]) + bf_hi(bw[e]); sm += o[2 * e] + o[2 * e + 1]; }
            sm += __shfl_xor(sm, 1); sm += __shfl_xor(sm, 2); sm += __shfl_xor(sm, 4);
            const float mu = sm * (1.0f / 64.0f); float qv = 0.f;
#pragma unroll
            for (int e = 0; e < 8; ++e) { o[e] -= mu; qv += o[e] * o[e]; }
            qv += __shfl_xor(qv, 1); qv += __shfl_xor(qv, 2); qv += __shfl_xor(qv, 4);
            const float rs = rsqrtf(qv * (1.0f / 64.0f) + NORM_EPS);
            float y[8];
#pragma unroll
            for (int e = 0; e < 4; ++e) { const float g0 = bf_lo(gwd[e]), g1 = bf_hi(gwd[e]);
                y[2 * e] = g0 / (1.0f + __expf(-g0)) * o[2 * e] * rs; y[2 * e + 1] = g1 / (1.0f + __expf(-g1)) * o[2 * e + 1] * rs; }
            u32x4 ow; ow.x = cvt_pk_bf16(y[0] * w0[0], y[1] * w0[1]); ow.y = cvt_pk_bf16(y[2] * w0[2], y[3] * w0[3]); ow.z = cvt_pk_bf16(y[4] * w1[0], y[5] * w1[1]); ow.w = cvt_pk_bf16(y[6] * w1[2], y[7] * w1[3]);
            *(u32x4*)(CAT + (size_t)(r0 + q) * 1024 + 512 + lane * 8) = ow; }
    }
}

__device__ __forceinline__ void fft_phase(Frame& F) {
    LAS unsigned char* B1 = F.lds; LAS unsigned char* B2 = F.lds + 32768; LAS bf16* Yall = (LAS bf16*)(F.lds + 49152); LAS bf16* Yw = Yall + F.wave * 4352;
    const int tid = F.tid, lane = F.lane, lr = lane & 15, lq = lane >> 4;
    for (int idx = tid; idx < 48 * 64; idx += 512) {
        const int fi = idx >> 6, ln = idx & 63; float v[8];
        if (fi < 32) { const int nt = fi >> 2, ks = fi & 3, pp = nt >> 2, rp = 16 * (nt & 3) + (ln & 15);
#pragma unroll
            for (int e = 0; e < 8; ++e) { const int k = 32 * ks + 8 * (ln >> 4) + e, pk = k >> 6, r = k & 63; float sn, cs; sincospif((float)((r * rp) & 63) * (1.0f / 32.0f), &sn, &cs);
                v[e] = 0.125f * ((pp == 0 && pk == 0) ? cs : ((pp == 1 && pk == 1) ? -cs : -sn)); } }
        else { const int f2 = fi - 32, ks2 = f2 >> 2, st = f2 & 3, sp = 16 * st + (ln & 15), pp = ks2 >> 1, stp = ks2 & 1;
#pragma unroll
            for (int e = 0; e < 8; ++e) { const int sidx = 16 * (2 * stp + (e >> 2)) + 4 * (ln >> 4) + (e & 3); float sn, cs; sincospif((float)((sidx * sp) & 63) * (1.0f / 32.0f), &sn, &cs);
                v[e] = 0.125f * (pp ? sn : cs); } }
        u32x4 o; o.x = cvt_pk_bf16(v[0], v[1]); o.y = cvt_pk_bf16(v[2], v[3]); o.z = cvt_pk_bf16(v[4], v[5]); o.w = cvt_pk_bf16(v[6], v[7]);
        *(LAS u32x4*)(F.lds + fi * 1024 + ln * 16) = o; }
    __syncthreads();
    SUBSTAMP(F, 0, 4);
    const bf16* ZT = (const bf16*)(F.ws + WS_ZT); bf16* CAT = (bf16*)(F.ws + WS_CAT);
    auto grp_of = [&](int git) -> int { int grp = git;
        if (F.G == 256) { const int it = git >> 8, c = git & 255, xcd = c & 7, i = c >> 3, k = (it * 4 + (i >> 3)) * 8 + xcd; grp = (k >> 3) * 64 + (k & 7) * 8 + (i & 7); }
        return grp; };
    bf16x8 a1[4][4];
    auto load_col = [&](int git) { const int grp = grp_of(git), b = grp >> 6, jg = grp & 63, j = jg * 8 + F.wave; const bf16* col = ZT + (size_t)(b * 512 + j) * 8192;
#pragma unroll
        for (int mt = 0; mt < 4; ++mt)
#pragma unroll
            for (int ks = 0; ks < 4; ++ks) a1[mt][ks] = *(const bf16x8*)(col + (ks >> 1) * 4096 + (16 * mt + lr) * 64 + 32 * (ks & 1) + 8 * lq); };
    if (F.c < 1024) load_col(F.c);
    for (int git = F.c; git < 1024; git += F.G) {
        const int grp = grp_of(git);
        const int b = grp >> 6, jg = grp & 63;
        const int gnext = (git + F.G < 1024) ? git + F.G : git;
#pragma unroll 1
        for (int rb = 0; rb < 4; ++rb) {
            f32x4 ur[4], ui[4];
#pragma unroll
            for (int mt = 0; mt < 4; ++mt) { ur[mt] = (f32x4){0.f, 0.f, 0.f, 0.f}; ui[mt] = (f32x4){0.f, 0.f, 0.f, 0.f}; }
#pragma unroll
            for (int ks = 0; ks < 4; ++ks) { const bf16x8 b1r = *(const LAS bf16x8*)(B1 + (rb * 4 + ks) * 1024 + lane * 16), b1i = *(const LAS bf16x8*)(B1 + ((rb + 4) * 4 + ks) * 1024 + lane * 16);
#pragma unroll
                for (int mt = 0; mt < 4; ++mt) { ur[mt] = __builtin_amdgcn_mfma_f32_16x16x32_bf16(a1[mt][ks], b1r, ur[mt], 0, 0, 0); ui[mt] = __builtin_amdgcn_mfma_f32_16x16x32_bf16(a1[mt][ks], b1i, ui[mt], 0, 0, 0); } }
            if (rb == 3) load_col(gnext);
            const int rp = 16 * rb + lr;
#pragma unroll
            for (int mt = 0; mt < 4; ++mt)
#pragma unroll
                for (int r = 0; r < 4; ++r) { const int sidx = 16 * mt + 4 * lq + r; const float x = (float)((sidx * rp) & 4095) * (1.0f / 4096.0f);
                    const float c = __builtin_amdgcn_cosf(x), sn = __builtin_amdgcn_sinf(x); const float tr = ur[mt][r] * c + ui[mt][r] * sn, ti = ui[mt][r] * c - ur[mt][r] * sn; ur[mt][r] = tr; ui[mt][r] = ti; }
            bf16x8 a2[4];
#pragma unroll
            for (int ks2 = 0; ks2 < 4; ++ks2) { const int stp = ks2 & 1; const f32x4 lo = (ks2 >> 1) ? ui[2 * stp] : ur[2 * stp], hi = (ks2 >> 1) ? ui[2 * stp + 1] : ur[2 * stp + 1];
                a2[ks2] = __builtin_bit_cast(bf16x8, pack8(lo, hi)); }
            f32x4 y[4];
#pragma unroll
            for (int st = 0; st < 4; ++st) y[st] = (f32x4){0.f, 0.f, 0.f, 0.f};
#pragma unroll
            for (int ks2 = 0; ks2 < 4; ++ks2)
#pragma unroll
                for (int st = 0; st < 4; ++st) { const bf16x8 b2f = *(const LAS bf16x8*)(B2 + (ks2 * 4 + st) * 1024 + lane * 16); y[st] = __builtin_amdgcn_mfma_f32_16x16x32_bf16(a2[ks2], b2f, y[st], 0, 0, 0); }
#pragma unroll
            for (int st = 0; st < 4; ++st) { u32x2 w; w.x = cvt_pk_bf16(y[st][0], y[st][1]); w.y = cvt_pk_bf16(y[st][2], y[st][3]); *(LAS u32x2*)(Yw + (16 * st + lr) * 68 + 16 * rb + 4 * lq) = w; }
        }
        __syncthreads();
#pragma unroll 2
        for (int it = 0; it < 8; ++it) { const int tp = tid + 512 * it, sp = tp >> 6, rp = tp & 63; unsigned short e[8];
#pragma unroll
            for (int w = 0; w < 8; ++w) e[w] = Yall[w * 4352 + sp * 68 + rp];
            u32x4 o; o.x = (unsigned)e[0] | ((unsigned)e[1] << 16); o.y = (unsigned)e[2] | ((unsigned)e[3] << 16); o.z = (unsigned)e[4] | ((unsigned)e[5] << 16); o.w = (unsigned)e[6] | ((unsigned)e[7] << 16);
            *(u32x4*)(CAT + (size_t)(NCTX + b * 4096 + tp) * 1024 + jg * 8) = o; }
        __syncthreads();
    }
}

__device__ __forceinline__ void router_phase(Frame& F, const Args& a, int l) {
    LAS unsigned char* wt = F.lds; LAS float* scr = (LAS float*)(F.lds + 131072 + F.wave * 2112); LAS unsigned* hist = (LAS unsigned*)(F.lds + 131072 + 16896);
    const int tid = F.tid, lane = F.lane, lr = lane & 15, lq = lane >> 4;
    { const u32x4* rt = (const u32x4*)(F.ws + WS_RT + (size_t)l * 131072); u32x4 tv[16];
#pragma unroll
      for (int i = 0; i < 16; ++i) tv[i] = rt[i * 512 + tid];
#pragma unroll
      for (int i = 0; i < 16; ++i) *(LAS u32x4*)(wt + (i * 512 + tid) * 16) = tv[i]; }
    if (tid < 32) hist[tid] = 0u;
    const float hsc = ((const float*)(F.ws + WS_HSC))[l * 2];
    __syncthreads();
    SUBSTAMP(F, l, 0);
    const int row_start = l ? NCTX : 0, ntask = (MT - row_start) / 16;
    const float* a12 = (const float*)(F.ws + WS_A12) + (size_t)(l * 2 + 1) * 17 * 1024; const float* modv = (const float*)(F.ws + WS_MODV) + (size_t)l * 17 * 6144;
    bf16* H = (bf16*)(F.ws + WS_H); int* tope = (int*)(F.ws + WS_TOPE); float* topg = (float*)(F.ws + WS_TOPG);
    const bf16* XB = (const bf16*)(F.ws + WS_XB); const float* ssp = (const float*)(F.ws + WS_SS);
    const float rb0 = a.in[I_RB][l * 32 + lr], rb1 = a.in[I_RB][l * 32 + 16 + lr];
    auto accumulate = [&](int task, int kb, int ke, f32x4& acc0, f32x4& acc1) {
        const int R0 = row_start + task * 16, row = R0 + lr, b = batch_of_row(R0);
        const bf16* xrow = XB + (size_t)row * 1024 + 8 * lq;
        const float* gp = a12 + (size_t)b * 1024 + 8 * lq; const float* sp = modv + (size_t)b * 6144 + 3072 + 8 * lq;
        float ss;
        { const f32x4* q = (const f32x4*)(ssp + (size_t)row * 16); const f32x4 s0 = q[0], s1 = q[1], s2 = q[2], s3 = q[3];
          ss = ((s0[0] + s0[1]) + (s0[2] + s0[3])) + ((s1[0] + s1[1]) + (s1[2] + s1[3])) + ((s2[0] + s2[1]) + (s2[2] + s2[3])) + ((s3[0] + s3[1]) + (s3[2] + s3[3])); }
        const float rn = rsqrtf(ss * (1.0f / 1024.0f) + NORM_EPS);
        acc0 = (f32x4){0.f, 0.f, 0.f, 0.f}; acc1 = acc0;
        unsigned char* h8row = F.ws + WS_H8 + (size_t)row * 1024 + 8 * lq;
        u32x4 xr[4];
#pragma unroll
        for (int u = 0; u < 4; ++u) xr[u] = *(const u32x4*)(xrow + 32 * (kb + u));
        for (int k4 = kb; k4 < ke; k4 += 4) {
            f32x4 xx[4][2], gg[4][2], sh[4][2]; u32x4 xn[4];
#pragma unroll
            for (int u = 0; u < 4; ++u) { const int ks = k4 + u;
                gg[u][0] = *(const f32x4*)(gp + 32 * ks); gg[u][1] = *(const f32x4*)(gp + 32 * ks + 4); sh[u][0] = *(const f32x4*)(sp + 32 * ks); sh[u][1] = *(const f32x4*)(sp + 32 * ks + 4); }
            { const int kn = (k4 + 4 < ke) ? k4 + 4 : k4;
#pragma unroll
              for (int u = 0; u < 4; ++u) xn[u] = *(const u32x4*)(xrow + 32 * (kn + u)); }
#pragma unroll
            for (int u = 0; u < 4; ++u) { const u32x4 w = xr[u]; xx[u][0] = (f32x4){bf_lo(w.x), bf_hi(w.x), bf_lo(w.y), bf_hi(w.y)}; xx[u][1] = (f32x4){bf_lo(w.z), bf_hi(w.z), bf_lo(w.w), bf_hi(w.w)}; }
#pragma unroll
            for (int u = 0; u < 4; ++u) { const int ks = k4 + u;
                const f32x4 h0 = xx[u][0] * rn * gg[u][0] + sh[u][0], h1 = xx[u][1] * rn * gg[u][1] + sh[u][1];
                const u32x4 hw = pack8(h0, h1);
                { u32x2 w8; w8.x = cvt4_fp8(h0[0] * hsc, h0[1] * hsc, h0[2] * hsc, h0[3] * hsc); w8.y = cvt4_fp8(h1[0] * hsc, h1[1] * hsc, h1[2] * hsc, h1[3] * hsc); *(u32x2*)(h8row + 32 * ks) = w8; }
                f32x4 l0, l1; l0[0] = h0[0] - bf_lo(hw.x); l0[1] = h0[1] - bf_hi(hw.x); l0[2] = h0[2] - bf_lo(hw.y); l0[3] = h0[3] - bf_hi(hw.y);
                l1[0] = h1[0] - bf_lo(hw.z); l1[1] = h1[1] - bf_hi(hw.z); l1[2] = h1[2] - bf_lo(hw.w); l1[3] = h1[3] - bf_hi(hw.w);
                const u32x4 lw = pack8(l0, l1);
                const bf16x8 ahi = __builtin_bit_cast(bf16x8, hw), alo = __builtin_bit_cast(bf16x8, lw);
                const bf16x8 b0h = *(const LAS bf16x8*)(wt + ((ks * 2 + 0) * 2 + 0) * 1024 + lane * 16), b0l = *(const LAS bf16x8*)(wt + ((ks * 2 + 0) * 2 + 1) * 1024 + lane * 16);
                const bf16x8 b1h = *(const LAS bf16x8*)(wt + ((ks * 2 + 1) * 2 + 0) * 1024 + lane * 16), b1l = *(const LAS bf16x8*)(wt + ((ks * 2 + 1) * 2 + 1) * 1024 + lane * 16);
                acc0 = __builtin_amdgcn_mfma_f32_16x16x32_bf16(ahi, b0h, acc0, 0, 0, 0); acc0 = __builtin_amdgcn_mfma_f32_16x16x32_bf16(ahi, b0l, acc0, 0, 0, 0); acc0 = __builtin_amdgcn_mfma_f32_16x16x32_bf16(alo, b0h, acc0, 0, 0, 0);
                acc1 = __builtin_amdgcn_mfma_f32_16x16x32_bf16(ahi, b1h, acc1, 0, 0, 0); acc1 = __builtin_amdgcn_mfma_f32_16x16x32_bf16(ahi, b1l, acc1, 0, 0, 0); acc1 = __builtin_amdgcn_mfma_f32_16x16x32_bf16(alo, b1h, acc1, 0, 0, 0); }
#pragma unroll
            for (int u = 0; u < 4; ++u) xr[u] = xn[u];
        }
    };
    auto route = [&](int task, const LAS float* src, int nsrc, int sstride) {
        if (lane < 16) {
            float v0 = -3.0e38f, v1 = -3.0e38f, v2 = -3.0e38f, v3 = -3.0e38f; int i0 = 0, i1 = 0, i2 = 0, i3 = 0;
#pragma unroll 4
            for (int e = 0; e < 32; ++e) { float x = src[lane * 33 + e]; for (int q = 1; q < nsrc; ++q) x += src[q * sstride + lane * 33 + e];
                if (x > v3) {
                    if (x > v0) { v3 = v2; i3 = i2; v2 = v1; i2 = i1; v1 = v0; i1 = i0; v0 = x; i0 = e; }
                    else if (x > v1) { v3 = v2; i3 = i2; v2 = v1; i2 = i1; v1 = x; i1 = e; }
                    else if (x > v2) { v3 = v2; i3 = i2; v2 = x; i2 = e; }
                    else { v3 = x; i3 = e; } } }
            const float e1 = __expf(v1 - v0), e2 = __expf(v2 - v0), e3 = __expf(v3 - v0), inv = 1.0f / (1.0f + e1 + e2 + e3);
            const int rr = row_start + task * 16 + lane;
            *(int4*)(tope + (size_t)rr * 4) = make_int4(i0, i1, i2, i3);
            *(f32x4*)(topg + (size_t)rr * 4) = (f32x4){inv, e1 * inv, e2 * inv, e3 * inv};
            lds_add(&hist[i0], 1u); lds_add(&hist[i1], 1u); lds_add(&hist[i2], 1u); lds_add(&hist[i3], 1u);
        }
    };
    const int NW = F.G * 8, nmain = (ntask / NW) * NW;
    for (int task = F.c * 8 + F.wave; task < nmain; task += NW) {
        f32x4 acc0, acc1; accumulate(task, 0, 32, acc0, acc1);
#pragma unroll
        for (int r = 0; r < 4; ++r) { scr[(4 * lq + r) * 33 + lr] = acc0[r] + rb0; scr[(4 * lq + r) * 33 + 16 + lr] = acc1[r] + rb1; }
        LDS_WAIT();
        route(task, scr, 1, 0);
        LDS_WAIT();
    }
    for (int task = nmain + F.c; task < ntask; task += F.G) {
        f32x4 acc0, acc1; accumulate(task, 4 * F.wave, 4 * F.wave + 4, acc0, acc1);
        const float c0 = F.wave == 0 ? rb0 : 0.f, c1 = F.wave == 0 ? rb1 : 0.f;
#pragma unroll
        for (int r = 0; r < 4; ++r) { scr[(4 * lq + r) * 33 + lr] = acc0[r] + c0; scr[(4 * lq + r) * 33 + 16 + lr] = acc1[r] + c1; }
        __syncthreads();
        if (F.wave == 0) route(task, (const LAS float*)(F.lds + 131072), 8, 528);
        __syncthreads();
    }
    SUBSTAMP(F, l, 1);
    LAS unsigned* lbase = hist + 32; LAS unsigned* lcur = hist + 64;
    asm volatile("s_waitcnt vmcnt(0)" ::: "memory");
    __syncthreads();
    if (tid < 32) { lbase[tid] = atomicAdd(F.ctl + CW_CUR + l * 64 + tid, hist[tid]); lcur[tid] = 0u; }
    __syncthreads();
    int* dest = (int*)(F.ws + WS_DEST); int* rlist = (int*)(F.ws + WS_RLIST);
    auto assign = [&](int task) { if (lane < 16) { const int rr = row_start + task * 16 + lane; const int4 ee = *(const int4*)(tope + (size_t)rr * 4); const int ev[4] = {ee.x, ee.y, ee.z, ee.w}; int dv[4];
#pragma unroll
            for (int k = 0; k < 4; ++k) { const unsigned pos = lbase[ev[k]] + lds_add(&lcur[ev[k]], 1u); rlist[(size_t)ev[k] * MT + pos] = rr; dv[k] = (ev[k] << 20) | (int)pos; }
            *(int4*)(dest + (size_t)rr * 4) = make_int4(dv[0], dv[1], dv[2], dv[3]); } };
    for (int task = F.c * 8 + F.wave; task < nmain; task += NW) assign(task);
    if (F.wave == 0) for (int task = nmain + F.c; task < ntask; task += F.G) assign(task);
}

__device__ __forceinline__ void dispatch_phase(Frame& F, int l) {
    LAS unsigned* L = (LAS unsigned*)F.lds;
    const int tid = F.tid;
    const int* tope = (const int*)(F.ws + WS_TOPE); int* dest = (int*)(F.ws + WS_DEST); int* rowmap = (int*)(F.ws + WS_ROWMAP); int* tile_e = (int*)(F.ws + WS_TILEE);
    if (tid < 32) { L[tid] = __hip_atomic_load(F.ctl + CW_CNT + l * 64 + tid, __ATOMIC_RELAXED, __HIP_MEMORY_SCOPE_AGENT); L[96 + tid] = 0u; L[128 + tid] = 0u; }
    __syncthreads();
    if (tid == 0) { unsigned off = 0; for (int e = 0; e < 32; ++e) { L[32 + e] = off; off += ((L[e] + 255u) >> 8) << 8; } L[64] = off; }
    __syncthreads();
    const int row_start = l ? NCTX : 0, nrows = MT - row_start, rpb = (nrows + F.G - 1) / F.G;
    const int r0 = row_start + F.c * rpb, r1 = (r0 + rpb < MT) ? r0 + rpb : MT, na = (r1 > r0 ? (r1 - r0) * 4 : 0);
    for (int i = tid; i < na; i += 512) lds_add(&L[96 + tope[(size_t)r0 * 4 + i]], 1u);
    __syncthreads();
    if (tid < 32) L[160 + tid] = atomicAdd(F.ctl + CW_CUR + l * 64 + tid, L[96 + tid]);
    __syncthreads();
    for (int i = tid; i < na; i += 512) { const int e = tope[(size_t)r0 * 4 + i]; const unsigned p = L[32 + e] + L[160 + e] + lds_add(&L[128 + e], 1u); rowmap[p] = r0 + (i >> 2); dest[(size_t)r0 * 4 + i] = (int)p; }
    if (F.c < 32) { const int e = F.c; const unsigned pe = L[32 + e] + L[e], pn = L[33 + e];
        for (unsigned p = pe + tid; p < pn; p += 512) rowmap[p] = row_start;
        for (unsigned t = (L[32 + e] >> 8) + tid; t < (pn >> 8); t += 512) tile_e[t] = e; }
    if (F.c == 0 && tid == 0) F.ctl[CW_NT + l * 64] = L[64] >> 8;
    __syncthreads();
}

typedef float f32x2v __attribute__((ext_vector_type(2)));
__device__ __forceinline__ void combine_phase(Frame& F, const Args& a, int l) {
    const int gw = F.c * 8 + F.wave, NGW = F.G * 8, lane = F.lane; constexpr int NR = 2;
    const LAS int* mtab = (const LAS int*)(F.lds + LDS_MOE);
    const int b32 = lane >> 1, esi = (b32 & 24) | ((b32 & 3) << 1) | ((b32 >> 2) & 1);
    const unsigned char* EOUT8 = F.ws + WS_EOUT8; const unsigned char* ES = F.ws + WS_ES; const int* dest = (const int*)(F.ws + WS_DEST); const float* topg = (const float*)(F.ws + WS_TOPG);
    const float* modv = (const float*)(F.ws + WS_MODV) + (size_t)l * 17 * 6144; bf16* XB = (bf16*)(F.ws + WS_XB); bf16* H = (bf16*)(F.ws + WS_H);
    const float* a12n = (const float*)(F.ws + WS_A12) + (size_t)(1 * 2 + 0) * 17 * 1024; const float* modvn = (const float*)(F.ws + WS_MODV) + (size_t)1 * 17 * 6144;
    for (int r0 = (l ? NCTX : 0) + gw * NR; r0 < MT; r0 += NGW * NR) {
        const int b = batch_of_row(r0);
        int4 d[NR]; f32x4 g[NR];
#pragma unroll
        for (int q = 0; q < NR; ++q) { d[q] = *(const int4*)(dest + (size_t)(r0 + q) * 4); g[q] = *(const f32x4*)(topg + (size_t)(r0 + q) * 4); }
        u32x4 ew[NR][4], xw[NR][2]; unsigned char sbv[NR][4]; f32x4 mg[4];
#pragma unroll
        for (int q = 0; q < NR; ++q) { const int dr[4] = {d[q].x, d[q].y, d[q].z, d[q].w}; int dd[4];
#pragma unroll
            for (int k = 0; k < 4; ++k) dd[k] = 256 * mtab[1152 + (dr[k] >> 20)] + (dr[k] & 0xFFFFF);
#pragma unroll
            for (int k = 0; k < 4; ++k) { ew[q][k] = *(const u32x4*)(EOUT8 + (size_t)dd[k] * 1024 + 16 * lane); sbv[q][k] = ES[(size_t)dd[k] * 32 + esi]; }
            xw[q][0] = *(const u32x4*)(XB + (size_t)(r0 + q) * 1024 + 16 * lane); xw[q][1] = *(const u32x4*)(XB + (size_t)(r0 + q) * 1024 + 16 * lane + 8); }
#pragma unroll
        for (int j = 0; j < 4; ++j) mg[j] = *(const f32x4*)(modv + (size_t)b * 6144 + 5120 + 16 * lane + 4 * j);
#pragma unroll
        for (int q = 0; q < NR; ++q) {
            f32x4 v[4]; float ss = 0.f;
#pragma unroll
            for (int j = 0; j < 4; ++j) v[j] = (f32x4){0.f, 0.f, 0.f, 0.f};
#pragma unroll
            for (int k = 0; k < 4; ++k) { const float sc = __uint_as_float((unsigned)sbv[q][k] << 23) * g[q][k]; const unsigned wv[4] = {ew[q][k].x, ew[q][k].y, ew[q][k].z, ew[q][k].w};
#pragma unroll
                for (int j = 0; j < 4; ++j) { const f32x2v lo = __builtin_amdgcn_cvt_pk_f32_fp8((int)wv[j], false), hi = __builtin_amdgcn_cvt_pk_f32_fp8((int)wv[j], true); v[j] += (f32x4){lo[0], lo[1], hi[0], hi[1]} * sc; } }
            const unsigned xv[8] = {xw[q][0].x, xw[q][0].y, xw[q][0].z, xw[q][0].w, xw[q][1].x, xw[q][1].y, xw[q][1].z, xw[q][1].w};
#pragma unroll
            for (int j = 0; j < 4; ++j) { v[j] = (f32x4){bf_lo(xv[2 * j]), bf_hi(xv[2 * j]), bf_lo(xv[2 * j + 1]), bf_hi(xv[2 * j + 1])} + mg[j] * v[j]; ss += (v[j][0] * v[j][0] + v[j][1] * v[j][1]) + (v[j][2] * v[j][2] + v[j][3] * v[j][3]); }
            const float rn = rsqrtf(wave_sum(ss) * (1.0f / 1024.0f) + NORM_EPS);
            if (l == 0) {
                const float* gain = a12n + (size_t)b * 1024 + 16 * lane; const float* shift = modvn + (size_t)b * 6144 + 16 * lane;
                *(u32x4*)(XB + (size_t)(r0 + q) * 1024 + 16 * lane) = pack8(v[0], v[1]); *(u32x4*)(XB + (size_t)(r0 + q) * 1024 + 16 * lane + 8) = pack8(v[2], v[3]);
                f32x4 hh[4];
#pragma unroll
                for (int j = 0; j < 4; ++j) hh[j] = v[j] * rn * *(const f32x4*)(gain + 4 * j) + *(const f32x4*)(shift + 4 * j);
                *(u32x4*)(H + (size_t)(r0 + q) * 1024 + 16 * lane) = pack8(hh[0], hh[1]); *(u32x4*)(H + (size_t)(r0 + q) * 1024 + 16 * lane + 8) = pack8(hh[2], hh[3]);
            } else {
                float* orow = a.out + (size_t)(r0 + q - NCTX) * 1024 + 16 * lane;
#pragma unroll
                for (int j = 0; j < 4; ++j) *(f32x4*)(orow + 4 * j) = v[j] * rn * *(const f32x4*)(a.in[I_FNW] + 16 * lane + 4 * j);
            }
        }
    }
}

__global__ void __launch_bounds__(512, 2) fwd_kernel(Args args) {
    extern __shared__ __attribute__((aligned(16))) unsigned char lds_raw[];
    Frame F;
    F.lds = (LAS unsigned char*)lds_raw; F.ws = args.ws; F.ctl = (unsigned*)(args.ws + WS_CTL);
    F.tid = threadIdx.x; F.lane = F.tid & 63; F.wave = __builtin_amdgcn_readfirstlane(F.tid >> 6); F.G = gridDim.x; F.c = blockIdx.x;
    volatile LAS unsigned* misc = (volatile LAS unsigned*)(F.lds + LDS_MISC);
    if (F.tid < 256) misc[F.tid] = 0u;
    __syncthreads();
    (void)xcd_barrier_post(F.ctl + CW_BAR, misc + 8);
#define GRID_BAR() do { size_t zb_ = 0; asm volatile("" : "+s"(zb_)); XcdBarrier bb_; bb_.bar = (unsigned*)(args.ws + zb_) + CW_BAR; bb_.x = xb_xcc_id(); bb_.st = (volatile LAS unsigned*)(F.lds + LDS_MISC) + 8; xcd_barrier(bb_); } while (0)
#if DIAG_A
    volatile LAS unsigned long long* tsl = (volatile LAS unsigned long long*)(F.lds + LDS_MISC + 64); int nst = 0;
#define STAMP() do { if (blockIdx.x == 0 && threadIdx.x == 0) tsl[nst] = wall_clock64(); ++nst; } while (0)
#else
#define STAMP() do {} while (0)
#endif
    STAMP();
#define FRESH() do { size_t z_ = 0; asm volatile("" : "+s"(z_)); F.ws = args.ws + z_; int t_ = threadIdx.x; asm volatile("" : "+v"(t_)); F.tid = t_; F.lane = t_ & 63; } while (0)

    for (int rep = 0; rep < DUP(0, 0); ++rep) { FRESH(); if (PH(0)) p0_prologue(F, args); }
    GRID_BAR(); STAMP();
    FRESH(); if (PH(1)) p0b_finalize(F, args);
    GRID_BAR(); STAMP();
    FRESH(); if (PH(1)) { p1_router_tables(F, args); p1_norm1_layer0(F, args); }
    GRID_BAR(); STAMP();

    for (int l = 0; l < 2; ++l) {
        for (int rep = 0; rep < DUP(2, l); ++rep) { FRESH(); if (PH(2)) { SchedInproj S{(const char*)(F.ws + WS_H), (const char*)(F.ws + WS_WQ) + (size_t)l * 2048 * 1024 * 2, (const char*)(F.ws + WS_WF) + (size_t)l * 1024 * 1024 * 2, F.G, F.c};
          EpiInproj E{(bf16*)(F.ws + WS_QKVG), (bf16*)(F.ws + WS_ZT), (bf16*)(F.ws + WS_ZTC), (const float*)(F.ws + WS_ROPE)};
          pg8::gemm_phase<EpiInproj, SchedInproj, false, true, true>(F.lds, 1024, S, E); } }
        GRID_BAR(); STAMP();
        for (int rep = 0; rep < DUP(3, l); ++rep) { FRESH(); if (PH(3)) retention_phase(F, args, l); }
        GRID_BAR(); STAMP();
        FRESH(); if (PH(4)) merge_phase(F, args, l); SUBSTAMP(F, l, 2);
        for (int rep = 0; rep < DUP(5, l); ++rep) { FRESH(); if (PH(5)) fft_phase(F); } SUBSTAMP(F, l, 3);
        FRESH(); if (PH(5) && l == 0) { SchedDftC S{(const char*)(F.ws + WS_DFTC), (const char*)(F.ws + WS_ZTC), F.G, F.c}; EpiCat E{(bf16*)(F.ws + WS_CAT), 0};
          pg8::gemm_phase<EpiCat, SchedDftC, false, true>(F.lds, 512, S, E); }
        GRID_BAR(); STAMP();
        for (int rep = 0; rep < DUP(6, l); ++rep) { FRESH(); if (PH(6)) { SchedReg S{(const char*)(F.ws + WS_CAT), (const char*)(F.ws + WS_WO) + (size_t)l * 1024 * 1024 * 2, l ? 256 : 272, 4, l ? 16 : 0, F.G, F.c, (size_t)256 * 1024 * 2};
          EpiRes E{args.in[I_X], args.in[I_CTX], (bf16*)(F.ws + WS_XB), (const float*)(F.ws + WS_MODV) + (size_t)l * 17 * 6144, (float*)(F.ws + WS_SS), l == 0 ? 1 : 0};
          pg8::gemm_phase<EpiRes, SchedReg, false, true>(F.lds, 1024, S, E); } }
        GRID_BAR(); STAMP();
        FRESH(); if (PH(7)) router_phase(F, args, l);
        GRID_BAR(); STAMP();
        FRESH(); const int nT = moe_tables(F, l);
        for (int rep = 0; rep < DUP(9, l); ++rep) { FRESH(); if (PH(9)) { SchedMoeQ S{(const char*)(F.ws + WS_H8), (const char*)(F.ws + WS_W1Q) + (size_t)l * 32 * 2048 * 1024, (const LAS int*)(F.lds + LDS_MOE), (const int*)(F.ws + WS_RLIST), l ? NCTX : 0, nT, 8, F.G, F.c, (size_t)2048 * 1024};
          const float hinv_ = __uint_as_float(__builtin_amdgcn_readfirstlane(__float_as_uint(((const float*)(F.ws + WS_HSC))[l * 2 + 1])));
          EpiW1Q E{F.ws + WS_ACT8, args.in[I_B1] + (size_t)l * 32 * 2048, (const float*)(F.ws + WS_W1CS) + (size_t)l * 32 * 2048, hinv_};
          pg8::gemm_phase_mx<EpiW1Q, SchedMoeQ, true>(F.lds, S, E); } }
        GRID_BAR(); STAMP();
        for (int rep = 0; rep < DUP(10, l); ++rep) { FRESH(); if (PH(10)) { SchedMoeQ S{(const char*)(F.ws + WS_ACT8), (const char*)(F.ws + WS_W2Q) + (size_t)l * 32 * 1024 * 1024, (const LAS int*)(F.lds + LDS_MOE), nullptr, 0, nT, 4, F.G, F.c, (size_t)1024 * 1024};
          EpiW2Q E{F.ws + WS_EOUT8, F.ws + WS_ES, args.in[I_B2] + (size_t)l * 32 * 1024, (const float*)(F.ws + WS_W2CS) + (size_t)l * 32 * 1024};
          pg8::gemm_phase_mx<EpiW2Q, SchedMoeQ, false>(F.lds, S, E); } }
        GRID_BAR(); STAMP();
        FRESH(); if (PH(11)) combine_phase(F, args, l);
        if (l == 0) { GRID_BAR(); STAMP(); }
    }
#if DIAG_A
    GRID_BAR(); STAMP();
    { if (threadIdx.x == 0 && blockIdx.x == 0) { ((float*)(args.ws + WS_MODP))[0] = (float)(tsl[DIAG_A] - tsl[DIAG_A0]) * 0.01f / (float)(DIAG_SA); ((float*)(args.ws + WS_MODP))[1] = (float)(tsl[DIAG_B] - tsl[DIAG_B0]) * 0.01f / (float)(DIAG_SB); }
      GRID_BAR();
      const float vA = ((volatile float*)(args.ws + WS_MODP))[0], vB = ((volatile float*)(args.ws + WS_MODP))[1];
      const size_t i = (size_t)blockIdx.x * 512 + threadIdx.x;
      if (i <= 65536) args.out[i] += (i == 0) ? vA : vB; }
#endif
}

extern "C" void kernel_launch(void* const* d_in, const int* in_sizes, int n_in, void* d_out, int out_size, void* d_ws, size_t ws_size, hipStream_t stream) {
    static int grid = 0;
    if (grid == 0) {
        if (n_in != 18 || out_size != NLAT * DM || ws_size < WS_END) { fprintf(stderr, "kernel_launch: unexpected shapes (n_in %d out %d ws %zu need %zu)\n", n_in, out_size, ws_size, (size_t)WS_END); grid = -1; return; }
        int dev = 0, cus = 0;
        if (hipGetDevice(&dev) != hipSuccess || hipDeviceGetAttribute(&cus, hipDeviceAttributeMultiprocessorCount, dev) != hipSuccess) { grid = -1; return; }
        if (hipFuncSetAttribute((const void*)fwd_kernel, hipFuncAttributeMaxDynamicSharedMemorySize, LDS_BYTES) != hipSuccess) { fprintf(stderr, "kernel_launch: hipFuncSetAttribute failed\n"); grid = -1; return; }
        int per_cu = 0;
        if (hipOccupancyMaxActiveBlocksPerMultiprocessor(&per_cu, (const void*)fwd_kernel, 512, LDS_BYTES) != hipSuccess || per_cu < 1) { fprintf(stderr, "kernel_launch: occupancy query says %d\n", per_cu); }
        (void)hipGetLastError();
        grid = cus;
    }
    if (grid < 0) return;
    (void)hipMemsetAsync((char*)d_ws + WS_CTL, 0, CTL_ZERO_BYTES, stream);
    Args a{};
    for (int i = 0; i < 18; ++i) a.in[i] = (const float*)d_in[i];
    a.out = (float*)d_out; a.ws = (unsigned char*)d_ws;
    hipLaunchKernelGGL(fwd_kernel, dim3(grid), dim3(512), LDS_BYTES, stream, a);
}
```

```cpp
#include <hip/hip_runtime.h>
#include <cstdio>
#include <cstdint>

#define LAS __attribute__((address_space(3)))
#define GAS __attribute__((address_space(1)))
typedef unsigned short bf16;
typedef short bf16x8 __attribute__((ext_vector_type(8)));
typedef float f32x4 __attribute__((ext_vector_type(4)));
typedef float f32x2 __attribute__((ext_vector_type(2)));
typedef unsigned u32x4 __attribute__((ext_vector_type(4)));
typedef unsigned u32x2 __attribute__((ext_vector_type(2)));

#ifndef DBG
#define DBG 0
#endif
#ifndef PHMASK
#define PHMASK 0xFFFF
#endif
#define PH(k) ((PHMASK >> (k)) & 1)
#ifndef DUPMASK
#define DUPMASK 0
#endif
#define DUP(k, l) (1 + (((DUPMASK >> (k)) & 1) && (l) == 0))
#ifndef DIAG_A
#define DIAG_A 0
#endif
#ifndef DIAG_B
#define DIAG_B 0
#endif
#ifndef DIAG_A0
#define DIAG_A0 (DIAG_A - 1)
#endif
#ifndef DIAG_B0
#define DIAG_B0 (DIAG_B - 1)
#endif
#ifndef DIAG_SA
#define DIAG_SA 100
#endif
#ifndef DIAG_SB
#define DIAG_SB 1000
#endif

constexpr int DM = 1024, NB = 16, TL = 4096, TCX = 256;
constexpr int NCTX = NB * TCX, NLAT = NB * TL, MT = NCTX + NLAT;
constexpr int NQ = 2048;
constexpr int NE = 32;
constexpr int MAXTILES = 1120, MAXROWS = MAXTILES * 256;
constexpr float NORM_EPS = 1e-6f;

constexpr size_t MiB = 1u << 20;
constexpr size_t WS_CTL = 0, CTL_ZERO_BYTES = 1 * MiB;
constexpr size_t WS_WQ = 1 * MiB;
constexpr size_t WS_WF = 9 * MiB;
constexpr size_t WS_WO = 13 * MiB;
constexpr size_t WS_W1 = 17 * MiB;
constexpr size_t WS_W2 = 273 * MiB;
constexpr size_t WS_DFT = 401 * MiB;
constexpr size_t WS_DFTC = 465 * MiB;
constexpr size_t WS_RLIST = WS_DFT + 16 * MiB;
constexpr size_t WS_MODP = WS_DFT;
constexpr size_t WS_MODV = 473 * MiB;
constexpr size_t WS_A12 = 474 * MiB;
constexpr size_t WS_ROPE = 475 * MiB;
constexpr size_t WS_RT = 475 * MiB + 512 * 1024;
constexpr size_t WS_TOPE = 476 * MiB;
constexpr size_t WS_TOPG = 478 * MiB;
constexpr size_t WS_DEST = 480 * MiB;
constexpr size_t WS_ROWMAP = 482 * MiB;
constexpr size_t WS_TILEE = 484 * MiB;
constexpr size_t WS_XCTX = 485 * MiB;
constexpr size_t WS_H = 501 * MiB;
constexpr size_t WS_MIX = 637 * MiB;
constexpr size_t WS_QKVG = WS_MIX;
constexpr size_t WS_ZT = WS_MIX + 272 * MiB;
constexpr size_t WS_ZTC = WS_MIX + 400 * MiB;
constexpr size_t WS_OF = WS_MIX + 408 * MiB;
constexpr size_t WS_OB = WS_MIX + 476 * MiB;
constexpr size_t WS_CAT = WS_MIX + 544 * MiB;
constexpr size_t WS_ACT = WS_MIX;
constexpr size_t WS_EOUT = 1317 * MiB;
constexpr size_t WS_SS = 1877 * MiB;
constexpr size_t WS_XB = 1882 * MiB;
constexpr size_t WS_END = 2018 * MiB;
constexpr size_t WS_W1Q = WS_W1;
constexpr size_t WS_W1CS = WS_W1 + 128 * MiB;
constexpr size_t WS_W2Q = WS_W2;
constexpr size_t WS_W2CS = WS_W2 + 64 * MiB;
constexpr size_t WS_HSC = WS_W2 + 66 * MiB;
constexpr size_t WS_H8 = WS_H;
constexpr size_t WS_EOUT8 = WS_EOUT;
constexpr size_t WS_ES = WS_EOUT + 300 * MiB;
constexpr size_t WS_ACT8 = WS_ACT;

static_assert(WS_CAT + (size_t)MT * 1024 * 2 <= WS_EOUT && WS_ACT + (size_t)MAXROWS * 1024 * 2 <= WS_EOUT, "ws map");

constexpr int CW_BAR = 4096;
constexpr int CW_CNT = 8192;
constexpr int CW_CUR = 8448;
constexpr int CW_NT = 8704;
constexpr int CW_CHK = 9216;

constexpr int LDS_BYTES = 155648;
constexpr int LDS_MOE = 131072 + 4096;
constexpr int LDS_MISC = 155648 - 1024;

#if DIAG_A
#define SUBSTAMP(F, l, k) do { if ((l) == 0 && blockIdx.x == 0 && threadIdx.x == 0) ((volatile LAS unsigned long long*)((F).lds + LDS_MISC + 64))[32 + (k)] = wall_clock64(); } while (0)
#else
#define SUBSTAMP(F, l, k) do {} while (0)
#endif
__device__ __forceinline__ unsigned cvt_pk_bf16(float lo, float hi) { unsigned r; asm volatile("v_cvt_pk_bf16_f32 %0, %1, %2" : "=v"(r) : "v"(lo), "v"(hi)); return r; }
__device__ __forceinline__ float bf_lo(unsigned w) { return __uint_as_float(w << 16); }
__device__ __forceinline__ float bf_hi(unsigned w) { return __uint_as_float(w & 0xffff0000u); }
__device__ __forceinline__ float bf2f(bf16 b) { return __uint_as_float(((unsigned)b) << 16); }
__device__ __forceinline__ float wave_sum(float v) {
#pragma unroll
    for (int o = 1; o < 64; o <<= 1) v += __shfl_xor(v, o);
    return v;
}
__device__ __forceinline__ unsigned lds_add(LAS unsigned* p, unsigned v) { return __hip_atomic_fetch_add(p, v, __ATOMIC_RELAXED, __HIP_MEMORY_SCOPE_WORKGROUP); }
__device__ __forceinline__ void mx_scale(float amax, int& sb, float& inv) { int be = (int)((__float_as_uint(amax) >> 23) & 0xffu) - 7; be = be < 1 ? 1 : be; sb = be; inv = __uint_as_float((unsigned)(254 - be) << 23); }
__device__ __forceinline__ unsigned cvt4_fp8(float a, float b, float c, float d) { int p = __builtin_amdgcn_cvt_pk_fp8_f32(a, b, 0, false); p = __builtin_amdgcn_cvt_pk_fp8_f32(c, d, p, true); return (unsigned)p; }
#define LDS_WAIT() asm volatile("s_waitcnt lgkmcnt(0)" ::: "memory")
#define VM_WAIT() asm volatile("s_waitcnt vmcnt(0)" ::: "memory")

#define XB_TMO      128
#define XB_XCNT(j)  (256  + 64 * (j))
#define XB_XSUB(j)  (1280 + 64 * (j))
#define XB_XGEN(j)  (2304 + 64 * (j))
#define XB_TOP      3328
#define XB_TOPGEN   3392
#define XCD_BAR_WORDS 3456
#define XB_SPIN_CAP (1u << 18)

__device__ __forceinline__ unsigned xb_ld(unsigned* p)              { return __hip_atomic_load(p, __ATOMIC_RELAXED, __HIP_MEMORY_SCOPE_AGENT); }
__device__ __forceinline__ unsigned xb_add(unsigned* p, unsigned v) { return __hip_atomic_fetch_add(p, v, __ATOMIC_RELAXED, __HIP_MEMORY_SCOPE_AGENT); }
__device__ __forceinline__ unsigned xb_xcc_id() { return (unsigned)__builtin_amdgcn_s_getreg((3 << 11) | 20) & 0xFu; }
#define XB_SPIN(cond, bar) do { unsigned _sp = 0; while (cond) { __builtin_amdgcn_s_sleep(1); \
    if ((++_sp & 255u) == 0u) { if (xb_ld(&(bar)[XB_TMO])) break; if (_sp > XB_SPIN_CAP) { atomicAdd(&(bar)[XB_TMO], 1u); break; } } } } while (0)

struct XcdBarrier {
    unsigned* bar; unsigned x;
    volatile LAS unsigned* st;
};
__device__ __forceinline__ XcdBarrier xcd_barrier_post(unsigned* bar, volatile LAS unsigned* st) {
    XcdBarrier b; b.bar = bar; b.x = xb_xcc_id(); b.st = st;
    if (threadIdx.x == 0) (void)xb_add(&bar[XB_XCNT(b.x)], 1u);
    return b;
}
__device__ __forceinline__ void xcd_barrier_complete(unsigned* bar, unsigned x, unsigned& nloc, unsigned& nx) {
    const unsigned G = gridDim.x * gridDim.y * gridDim.z;
    unsigned sum, cnt, mine, sp = 0u;
    for (;;) {
        sum = 0u; cnt = 0u; mine = 0u;
#pragma unroll
        for (unsigned j = 0; j < 16; ++j) { const unsigned c = xb_ld(&bar[XB_XCNT(j)]); sum += c; cnt += (c > 0u) ? 1u : 0u; mine = (j == x) ? c : mine; }
        if (sum == G) break;
        __builtin_amdgcn_s_sleep(1);
        if ((++sp & 255u) == 0u) { if (xb_ld(&bar[XB_TMO])) break; if (sp > XB_SPIN_CAP) { atomicAdd(&bar[XB_TMO], 1u); break; } }
    }
    nloc = mine > 0u ? mine : 1u; nx = cnt > 0u ? cnt : 1u;
}
__device__ __forceinline__ void xcd_barrier(const XcdBarrier& b) {
    asm volatile("s_waitcnt vmcnt(0)" ::: "memory");
    __syncthreads();
    if (threadIdx.x == 0) {
        unsigned* bar = b.bar;
        __builtin_amdgcn_s_waitcnt(0);
        unsigned nloc = b.st[0], nx = b.st[1];
        if (nloc == 0u) { xcd_barrier_complete(bar, b.x, nloc, nx); b.st[0] = nloc; b.st[1] = nx; }
        const unsigned old = xb_add(&bar[XB_XSUB(b.x)], 1u);
        const unsigned gen = old / nloc;
        if (old + 1u == (gen + 1u) * nloc) {
            __builtin_amdgcn_fence(__ATOMIC_RELEASE, "agent");
            asm volatile("s_waitcnt vmcnt(0)" ::: "memory");
            const unsigned og = xb_add(&bar[XB_TOP], 1u);
            const unsigned tg = og / nx;
            if (og + 1u == (tg + 1u) * nx) xb_add(&bar[XB_TOPGEN], 1u);
            else XB_SPIN(xb_ld(&bar[XB_TOPGEN]) == tg, bar);
            __builtin_amdgcn_fence(__ATOMIC_ACQUIRE, "agent");
            xb_add(&bar[XB_XGEN(b.x)], 1u);
            asm volatile("s_waitcnt vmcnt(0)" ::: "memory");
        } else {
            XB_SPIN(xb_ld(&bar[XB_XGEN(b.x)]) == gen, bar);
            __builtin_amdgcn_fence(__ATOMIC_ACQUIRE, "agent");
            asm volatile("s_waitcnt vmcnt(0)" ::: "memory");
        }
    }
    __syncthreads();
}

namespace pg8 {
constexpr int BM = 256, BK = 64, HALF = 128, HTB = HALF * BK * 2, STAGE_BYTES = 8 * HTB, NXCD = 8, WGM = 8;
__host__ __device__ __forceinline__ int lds_byte(int r, int c) { const int st = (r >> 4) * 2 + (c >> 5), rr = r & 15, cc = c & 31, ob = rr * 64 + cc * 2; return st * 1024 + (ob ^ (((ob >> 9) & 1) << 5)); }
__host__ __device__ __forceinline__ void stage_rc(int b, int& R, int& C) { const int st = b / 1024, sb = b % 1024, swz = sb ^ (((sb >> 9) & 1) << 5); R = (st >> 1) * 16 + swz / 64; C = (st & 1) * 32 + (swz % 64) / 2; }
__host__ __device__ __forceinline__ int perm32(int rho) { const int n = rho >> 4, i = rho & 15; return 8 * (i >> 2) + 4 * n + (i & 3); }

struct Unit { const char* A; const char* B; int pm, pn, e; };

__device__ __forceinline__ void tile_of(int L, int nM, int nN, int& pm, int& pn) {
    const int nwg = nM * nN; int wgid = L;
    { const int q = nwg / NXCD, r = nwg % NXCD, xcd = wgid % NXCD, off = wgid / NXCD; wgid = (xcd < r ? xcd * (q + 1) : r * (q + 1) + (xcd - r) * q) + off; }
    const int nig = WGM * nN, gid = wgid / nig, fm = gid * WGM, gsz = (nM - fm) < WGM ? (nM - fm) : WGM;
    pm = fm + ((wgid % nig) % gsz); pn = (wgid % nig) / gsz;
}

template <class Epi, class Sched, bool GATHER, bool ALIGN_EPI, bool BPERM = false>
__device__ __forceinline__ void gemm_phase(LAS unsigned char* lds, const int K, const Sched& S, const Epi& E) {
    int tid_ = threadIdx.x; asm volatile("" : "+v"(tid_));
    const int tid = tid_, wid = __builtin_amdgcn_readfirstlane(tid >> 6), lane = tid & 63, wr = wid >> 2, wc = wid & 3, fr = lane & 15, fq = lane >> 4;
    const int nt = K / BK;
    unsigned voffBn[2][2], voffBp[2][2], cAo[2][2], nAo[2][2]; int Rl[2], Cl[2];
#pragma unroll
    for (int i = 0; i < 2; ++i) { int R, C; stage_rc(tid * 16 + i * 8192, R, C); Rl[i] = R; Cl[i] = C; const int Rb = Epi::PERM ? ((R & ~31) + perm32(R & 31)) : R;
        voffBn[0][i] = (unsigned)(Rb * K + C) * 2u; voffBn[1][i] = (unsigned)((Rb + HALF) * K + C) * 2u;
        voffBp[0][i] = (unsigned)((64 * (Rb & 63) + (Rb >> 6)) * K + C) * 2u - voffBn[0][i]; voffBp[1][i] = (unsigned)((64 * (Rb & 63) + 2 + (Rb >> 6)) * K + C) * 2u - voffBn[1][i];
        cAo[0][i] = (unsigned)(R * K + C) * 2u; cAo[1][i] = (unsigned)((R + HALF) * K + C) * 2u; nAo[0][i] = cAo[0][i]; nAo[1][i] = cAo[1][i]; }
    const size_t kstep = (size_t)(BK * 2);
    const unsigned ldsw = (unsigned)wid * 1024u;
    const int aoff = lds_byte(wr * 64 + fr, fq * 8), boff = lds_byte(wc * 32 + fr, fq * 8);
#define PG8_SA(b, h) (((b) * 2 + (h)) * HTB)
#define PG8_SB(b, h) ((4 + (b) * 2 + (h)) * HTB)
#define PG8_STAGE_B(bufoff, gbase, offs, h) do { _Pragma("unroll") for (int _i = 0; _i < 2; ++_i) { unsigned _o = (offs)[h][_i]; asm volatile("" : "+v"(_o));     \
        __builtin_amdgcn_global_load_lds((const unsigned*)((const char*)(gbase) + _o), (LAS unsigned*)(lds + (bufoff) + ldsw + _i * 8192), 16, 0, 0); } } while (0)
#define PG8_STAGE_A(bufoff, gbase, offs, h) do { _Pragma("unroll") for (int _i = 0; _i < 2; ++_i) { unsigned _o = (offs)[h][_i]; asm volatile("" : "+v"(_o)); \
        __builtin_amdgcn_global_load_lds((const unsigned*)((const char*)(gbase) + _o), (LAS unsigned*)(lds + (bufoff) + ldsw + _i * 8192), 16, 0, 0); } } while (0)
#define PG8_LDA(dst, b, h) do { _Pragma("unroll") for (int m = 0; m < 4; ++m) _Pragma("unroll") for (int k = 0; k < 2; ++k) dst[m][k] = *(const LAS bf16x8*)(lds + PG8_SA(b, h) + aoff + m * 2048 + k * 1024); } while (0)
#define PG8_LDB(dst, b, h) do { _Pragma("unroll") for (int n = 0; n < 2; ++n) _Pragma("unroll") for (int k = 0; k < 2; ++k) dst[n][k] = *(const LAS bf16x8*)(lds + PG8_SB(b, h) + boff + n * 2048 + k * 1024); } while (0)
#define PG8_MMA(ai, bj, At, Bt) do { __builtin_amdgcn_s_setprio(1); _Pragma("unroll") for (int m = 0; m < 4; ++m) _Pragma("unroll") for (int n = 0; n < 2; ++n) _Pragma("unroll") for (int k = 0; k < 2; ++k) \
        acc[ai][bj][m][n] = __builtin_amdgcn_mfma_f32_16x16x32_bf16(Bt[n][k], At[m][k], acc[ai][bj][m][n], 0, 0, 0); __builtin_amdgcn_s_setprio(0); } while (0)
#define PG8_WAIT_V(n) asm volatile("s_waitcnt vmcnt(" #n ")" ::: "memory")
#define PG8_WAIT_L(n) asm volatile("s_waitcnt lgkmcnt(" #n ")" ::: "memory")
#define PG8_BAR __builtin_amdgcn_s_barrier()
#define PG8_SCHED __builtin_amdgcn_sched_barrier(0)
    Unit cur, nxt; int ui = 0;
    if (!S.next(0, cur)) return;
    if constexpr (GATHER) S.rowoffs(cur, Rl, Cl, cAo);
    unsigned cfl = (BPERM && cur.e == 2) ? 1u : 0u, nfl = cfl;
    unsigned cBo[2][2];
#pragma unroll
    for (int h = 0; h < 2; ++h)
#pragma unroll
        for (int i = 0; i < 2; ++i) cBo[h][i] = BPERM ? voffBn[h][i] + cfl * voffBp[h][i] : voffBn[h][i];
    f32x4 acc[2][2][4][2];
#pragma unroll
    for (int a = 0; a < 2; ++a)
#pragma unroll
        for (int b = 0; b < 2; ++b)
#pragma unroll
            for (int m = 0; m < 4; ++m)
#pragma unroll
                for (int n = 0; n < 2; ++n) acc[a][b][m][n] = (f32x4){0.f, 0.f, 0.f, 0.f};
    bf16x8 At[4][2], B0[2][2], B1[2][2];
    const char* cA = cur.A; const char* cB = cur.B;
    PG8_STAGE_B(PG8_SB(0, 0), cB, cBo, 0); PG8_STAGE_B(PG8_SB(0, 1), cB, cBo, 1); PG8_STAGE_A(PG8_SA(0, 0), cA, cAo, 0); PG8_STAGE_A(PG8_SA(0, 1), cA, cAo, 1);
    if (wr == 1) PG8_BAR;
    PG8_WAIT_V(2); PG8_BAR;
    PG8_STAGE_B(PG8_SB(1, 0), cB + kstep, cBo, 0); PG8_STAGE_A(PG8_SA(1, 0), cA + kstep, cAo, 0); PG8_STAGE_B(PG8_SB(1, 1), cB + kstep, cBo, 1);
    PG8_WAIT_V(6); PG8_BAR;
    for (;;) {
        const bool has_next = S.next(ui + 1, nxt);
        const char* nA = has_next ? nxt.A : cA; const char* nB = has_next ? nxt.B : cB;
        if constexpr (GATHER) { if (has_next) S.rowoffs(nxt, Rl, Cl, nAo); else { nAo[0][0] = cAo[0][0]; nAo[0][1] = cAo[0][1]; nAo[1][0] = cAo[1][0]; nAo[1][1] = cAo[1][1]; } }
        if constexpr (BPERM) nfl = has_next ? ((nxt.e == 2) ? 1u : 0u) : cfl;
        for (int t = 0; t < nt; t += 2) {
            const bool last = (t == nt - 2);
            const char* a1 = cA + (size_t)(t + 1) * kstep;
            const char* a2 = last ? nA : cA + (size_t)(t + 2) * kstep; const char* b2 = last ? nB : cB + (size_t)(t + 2) * kstep;
            const char* a3 = a2 + kstep; const char* b3 = b2 + kstep;
            unsigned o2[2][2];
#pragma unroll
            for (int h = 0; h < 2; ++h)
#pragma unroll
                for (int i = 0; i < 2; ++i) o2[h][i] = (GATHER && last) ? nAo[h][i] : cAo[h][i];
            unsigned ob2[2][2]; const unsigned fl2 = last ? nfl : cfl;
#pragma unroll
            for (int h = 0; h < 2; ++h)
#pragma unroll
                for (int i = 0; i < 2; ++i) ob2[h][i] = BPERM ? voffBn[h][i] + fl2 * voffBp[h][i] : voffBn[h][i];
            PG8_LDB(B0, 0, 0); PG8_LDB(B1, 0, 1); PG8_SCHED; PG8_LDA(At, 0, 0); PG8_STAGE_A(PG8_SA(1, 1), a1, cAo, 1);
            PG8_WAIT_V(8); PG8_WAIT_L(0); PG8_BAR; PG8_MMA(0, 0, At, B0); PG8_MMA(0, 1, At, B1); PG8_BAR; PG8_SCHED;
            PG8_LDA(At, 0, 1); PG8_STAGE_B(PG8_SB(0, 0), b2, ob2, 0); PG8_STAGE_B(PG8_SB(0, 1), b2, ob2, 1); PG8_STAGE_A(PG8_SA(0, 0), a2, o2, 0);
            PG8_WAIT_V(8); PG8_WAIT_L(0); PG8_BAR; PG8_MMA(1, 0, At, B0); PG8_MMA(1, 1, At, B1); PG8_BAR; PG8_SCHED;
            PG8_LDB(B0, 1, 0); PG8_LDB(B1, 1, 1); PG8_SCHED; PG8_LDA(At, 1, 0); PG8_STAGE_A(PG8_SA(0, 1), a2, o2, 1);
            PG8_WAIT_V(8); PG8_WAIT_L(0); PG8_BAR; PG8_MMA(0, 0, At, B0); PG8_MMA(0, 1, At, B1); PG8_BAR; PG8_SCHED;
            PG8_LDA(At, 1, 1); PG8_STAGE_B(PG8_SB(1, 0), b3, ob2, 0); PG8_STAGE_B(PG8_SB(1, 1), b3, ob2, 1); PG8_STAGE_A(PG8_SA(1, 0), a3, o2, 0);
            PG8_WAIT_V(8); PG8_WAIT_L(0); PG8_BAR; PG8_MMA(1, 0, At, B0); PG8_MMA(1, 1, At, B1); PG8_BAR; PG8_SCHED;
        }
        if constexpr (ALIGN_EPI) { if (wr == 0) PG8_BAR; }
        E(acc, cur, wr, wc, fr, fq);
        if (!has_next) break;
#pragma unroll
        for (int a = 0; a < 2; ++a)
#pragma unroll
            for (int b = 0; b < 2; ++b)
#pragma unroll
                for (int m = 0; m < 4; ++m)
#pragma unroll
                    for (int n = 0; n < 2; ++n) acc[a][b][m][n] = (f32x4){0.f, 0.f, 0.f, 0.f};
        cur = nxt; cA = nA; cB = nB; ++ui;
        if constexpr (GATHER) { cAo[0][0] = nAo[0][0]; cAo[0][1] = nAo[0][1]; cAo[1][0] = nAo[1][0]; cAo[1][1] = nAo[1][1]; }
        if constexpr (BPERM) { cfl = nfl;
#pragma unroll
            for (int h = 0; h < 2; ++h)
#pragma unroll
                for (int i = 0; i < 2; ++i) cBo[h][i] = voffBn[h][i] + cfl * voffBp[h][i]; }
        if constexpr (ALIGN_EPI) { if (wr == 1) PG8_BAR; }
    }
    PG8_WAIT_V(0);
    if constexpr (!ALIGN_EPI) { if (wr == 0) PG8_BAR; }
    PG8_BAR;
#undef PG8_SA
#undef PG8_SB
#undef PG8_STAGE_A
#undef PG8_STAGE_B
#undef PG8_LDA
#undef PG8_LDB
#undef PG8_MMA
#undef PG8_WAIT_V
#undef PG8_WAIT_L
#undef PG8_BAR
#undef PG8_SCHED
}

typedef int v8i_t __attribute__((ext_vector_type(8)));
typedef int v4i_t __attribute__((ext_vector_type(4)));
__device__ __forceinline__ v8i_t cat8(const bf16x8 lo, const bf16x8 hi) { return __builtin_shufflevector(__builtin_bit_cast(v4i_t, lo), __builtin_bit_cast(v4i_t, hi), 0, 1, 2, 3, 4, 5, 6, 7); }
template <class Epi, class Sched, bool GATHER>
__device__ __forceinline__ void gemm_phase_mx(LAS unsigned char* lds, const Sched& S, const Epi& E) {
    int tid_ = threadIdx.x; asm volatile("" : "+v"(tid_));
    const int tid = tid_, wid = __builtin_amdgcn_readfirstlane(tid >> 6), lane = tid & 63, wr = wid >> 2, wc = wid & 3, fr = lane & 15, fq = lane >> 4;
    constexpr int KB = 1024; int nt = 8; asm volatile("" : "+s"(nt));
    unsigned voffBn[2][2], cAo[2][2], nAo[2][2];
#pragma unroll
    for (int i = 0; i < 2; ++i) { int R, C; stage_rc(tid * 16 + i * 8192, R, C); const int Rb = Epi::PERM ? ((R & ~31) + perm32(R & 31)) : R;
        voffBn[0][i] = (unsigned)(Rb * KB + 2 * C); voffBn[1][i] = (unsigned)((Rb + HALF) * KB + 2 * C);
        cAo[0][i] = (unsigned)(R * KB + 2 * C); cAo[1][i] = (unsigned)((R + HALF) * KB + 2 * C); nAo[0][i] = cAo[0][i]; nAo[1][i] = cAo[1][i]; }
    const size_t kstep = 128;
    const unsigned ldsw = (unsigned)wid * 1024u;
    const int aoff = lds_byte(wr * 64 + fr, fq * 8), boff = lds_byte(wc * 32 + fr, fq * 8);
    int one = 0x7f7f7f7f; asm volatile("" : "+v"(one));
#define PG8_SA(b, h) (((b) * 2 + (h)) * HTB)
#define PG8_SB(b, h) ((4 + (b) * 2 + (h)) * HTB)
#define PG8_STAGE_B(bufoff, gbase, offs, h) do { _Pragma("unroll") for (int _i = 0; _i < 2; ++_i) { unsigned _o = (offs)[h][_i]; asm volatile("" : "+v"(_o));     \
        __builtin_amdgcn_global_load_lds((const unsigned*)((const char*)(gbase) + _o), (LAS unsigned*)(lds + (bufoff) + ldsw + _i * 8192), 16, 0, 0); } } while (0)
#define PG8_STAGE_A(bufoff, gbase, offs, h) PG8_STAGE_B(bufoff, gbase, offs, h)
#define PG8_LDA(dst, b, h) do { _Pragma("unroll") for (int m = 0; m < 4; ++m) dst[m] = cat8(*(const LAS bf16x8*)(lds + PG8_SA(b, h) + aoff + m * 2048), *(const LAS bf16x8*)(lds + PG8_SA(b, h) + aoff + m * 2048 + 1024)); } while (0)
#define PG8_LDB(dst, b, h) do { _Pragma("unroll") for (int n = 0; n < 2; ++n) dst[n] = cat8(*(const LAS bf16x8*)(lds + PG8_SB(b, h) + boff + n * 2048), *(const LAS bf16x8*)(lds + PG8_SB(b, h) + boff + n * 2048 + 1024)); } while (0)
#define PG8_MXA(accv, bt, at) asm volatile("v_mfma_scale_f32_16x16x128_f8f6f4 %0, %1, %2, %0, %3, %3 op_sel_hi:[0,0,0]" : "+v"(accv) : "v"(bt), "v"(at), "v"(one))
#define PG8_MXAZ(accv, bt, at) asm volatile("v_mfma_scale_f32_16x16x128_f8f6f4 %0, %1, %2, 0, %3, %3 op_sel_hi:[0,0,0]" : "=v"(accv) : "v"(bt), "v"(at), "v"(one))
#define PG8_MMAZ(ai, bj, At, Bt) do { __builtin_amdgcn_s_setprio(1); _Pragma("unroll") for (int m = 0; m < 4; ++m) _Pragma("unroll") for (int n = 0; n < 2; ++n) PG8_MXAZ(acc[ai][bj][m][n], Bt[n], At[m]); __builtin_amdgcn_s_setprio(0); } while (0)
#define PG8_MMA(ai, bj, At, Bt) do { __builtin_amdgcn_s_setprio(1); _Pragma("unroll") for (int m = 0; m < 4; ++m) _Pragma("unroll") for (int n = 0; n < 2; ++n) PG8_MXA(acc[ai][bj][m][n], Bt[n], At[m]); __builtin_amdgcn_s_setprio(0); } while (0)
#define PG8_WAIT_V(n) asm volatile("s_waitcnt vmcnt(" #n ")" ::: "memory")
#define PG8_WAIT_L(n) asm volatile("s_waitcnt lgkmcnt(" #n ")" ::: "memory")
#define PG8_BAR __builtin_amdgcn_s_barrier()
#define PG8_SCHED __builtin_amdgcn_sched_barrier(0)
    constexpr int SIDE = 131072;
#define PG8_SIDE(u_, slot_) do { const float* sp_ = (wid < 4) ? E.sideA(u_) + 64 * wid : E.sideB(u_) + 64 * (wid - 4); \
        __builtin_amdgcn_global_load_lds((const unsigned*)(sp_ + lane), (LAS unsigned*)(lds + SIDE + (slot_) * 2048 + wid * 256), 4, 0, 0); } while (0)
    Unit cur, nxt; int ui = 0;
    if (!S.next(0, cur)) return;
    if constexpr (GATHER) S.rowoffs(cur, tid, cAo);
    PG8_SIDE(cur, 0);
    f32x4 acc[2][2][4][2];
    v8i_t At[4], B0[2], B1[2];
    const char* cA = cur.A; const char* cB = cur.B;
    PG8_STAGE_B(PG8_SB(0, 0), cB, voffBn, 0); PG8_STAGE_B(PG8_SB(0, 1), cB, voffBn, 1); PG8_STAGE_A(PG8_SA(0, 0), cA, cAo, 0); PG8_STAGE_A(PG8_SA(0, 1), cA, cAo, 1);
    if (wr == 1) PG8_BAR;
    PG8_WAIT_V(2); PG8_BAR;
    PG8_STAGE_B(PG8_SB(1, 0), cB + kstep, voffBn, 0); PG8_STAGE_A(PG8_SA(1, 0), cA + kstep, cAo, 0); PG8_STAGE_B(PG8_SB(1, 1), cB + kstep, voffBn, 1);
    PG8_WAIT_V(6); PG8_BAR;
    for (;;) {
        const bool has_next = S.next(ui + 1, nxt);
        const char* nA = has_next ? nxt.A : cA; const char* nB = has_next ? nxt.B : cB;
        if constexpr (GATHER) { if (has_next) S.rowoffs(nxt, tid, nAo); else { nAo[0][0] = cAo[0][0]; nAo[0][1] = cAo[0][1]; nAo[1][0] = cAo[1][0]; nAo[1][1] = cAo[1][1]; } }
        for (int t = 0; t < nt; t += 2) {
            const bool last = (t == nt - 2);
            const char* a1 = cA + (size_t)(t + 1) * kstep;
            const char* a2 = last ? nA : cA + (size_t)(t + 2) * kstep; const char* b2 = last ? nB : cB + (size_t)(t + 2) * kstep;
            const char* a3 = a2 + kstep; const char* b3 = b2 + kstep;
            PG8_LDB(B0, 0, 0); PG8_LDB(B1, 0, 1); PG8_SCHED; PG8_LDA(At, 0, 0); PG8_STAGE_A(PG8_SA(1, 1), a1, cAo, 1);
            if constexpr (GATHER) { if (last) { cAo[0][0] = nAo[0][0]; cAo[0][1] = nAo[0][1]; cAo[1][0] = nAo[1][0]; cAo[1][1] = nAo[1][1]; } }
            PG8_WAIT_V(8); PG8_WAIT_L(0); PG8_BAR; if (t == 0 && has_next) PG8_SIDE(nxt, (ui + 1) & 1); if (t == 0) { PG8_MMAZ(0, 0, At, B0); PG8_MMAZ(0, 1, At, B1); } else { PG8_MMA(0, 0, At, B0); PG8_MMA(0, 1, At, B1); } PG8_BAR; PG8_SCHED;
            PG8_LDA(At, 0, 1); PG8_STAGE_B(PG8_SB(0, 0), b2, voffBn, 0); PG8_STAGE_B(PG8_SB(0, 1), b2, voffBn, 1); PG8_STAGE_A(PG8_SA(0, 0), a2, cAo, 0);
            PG8_WAIT_V(8); PG8_WAIT_L(0); PG8_BAR; if (t == 0) { PG8_MMAZ(1, 0, At, B0); PG8_MMAZ(1, 1, At, B1); } else { PG8_MMA(1, 0, At, B0); PG8_MMA(1, 1, At, B1); } PG8_BAR; PG8_SCHED;
            PG8_LDB(B0, 1, 0); PG8_LDB(B1, 1, 1); PG8_SCHED; PG8_LDA(At, 1, 0); PG8_STAGE_A(PG8_SA(0, 1), a2, cAo, 1);
            PG8_WAIT_V(8); PG8_WAIT_L(0); PG8_BAR; PG8_MMA(0, 0, At, B0); PG8_MMA(0, 1, At, B1); PG8_BAR; PG8_SCHED;
            PG8_LDA(At, 1, 1); PG8_STAGE_B(PG8_SB(1, 0), b3, voffBn, 0); PG8_STAGE_B(PG8_SB(1, 1), b3, voffBn, 1); PG8_STAGE_A(PG8_SA(1, 0), a3, cAo, 0);
            PG8_WAIT_V(8); PG8_WAIT_L(0); PG8_BAR; PG8_MMA(1, 0, At, B0); PG8_MMA(1, 1, At, B1); PG8_BAR; PG8_SCHED;
        }
        if (wr == 0) PG8_BAR;
        asm volatile("s_nop 15\n\ts_nop 15" ::: "memory");
        E(acc, cur, wr, wc, fr, fq, (const LAS float*)(lds + SIDE + (ui & 1) * 2048));
        if (!has_next) break;
        cur = nxt; cA = nA; cB = nB; ++ui;
        if (wr == 1) PG8_BAR;
    }
    PG8_WAIT_V(0);
    PG8_BAR;
#undef PG8_SA
#undef PG8_SB
#undef PG8_STAGE_A
#undef PG8_STAGE_B
#undef PG8_LDA
#undef PG8_LDB
#undef PG8_MXA
#undef PG8_MXAZ
#undef PG8_MMAZ
#undef PG8_SIDE
#undef PG8_MMA
#undef PG8_WAIT_V
#undef PG8_WAIT_L
#undef PG8_BAR
#undef PG8_SCHED
}
}
using pg8::Unit;
typedef const f32x4 (&AccRef)[2][2][4][2];

struct Args { const float* in[18]; float* out; unsigned char* ws; };
enum { I_X = 0, I_C, I_CTX, I_CCTX, I_MODW, I_MODB, I_NORMW, I_WIN, I_WOUT, I_DECAY, I_RNW, I_RW, I_RB, I_W1, I_B1, I_W2, I_B2, I_FNW };

struct Frame {
    LAS unsigned char* lds;
    unsigned char* ws;
    unsigned* ctl;
    int tid, lane, wave, G, c;
};
__device__ __forceinline__ int batch_of_row(int r) { return r < NCTX ? 16 : ((r - NCTX) >> 12); }

struct SchedReg {
    const char* A; const char* B; int nM, nN, pm0, G, c; size_t tstep;
    __device__ __forceinline__ bool next(int i, Unit& u) const {
        const int L = i * G + c; if (L >= nM * nN) return false;
        int pm, pn; pg8::tile_of(L, nM, nN, pm, pn); u.pm = pm + pm0; u.pn = pn; u.e = 0;
        u.A = A + (size_t)u.pm * tstep; u.B = B + (size_t)pn * tstep; return true; }
};
struct SchedInproj {
    const char* H; const char* Wq; const char* Wf; int G, c;
    __device__ __forceinline__ bool next(int i, Unit& u) const {
        const int L = i * G + c; constexpr size_t tstep = (size_t)256 * 1024 * 2;
        if (L >= 3264) return false;
        int pm, pn;
        if (L < 2176) { pg8::tile_of(L, 272, 8, pm, pn); u.e = 0; u.A = H + (size_t)pm * tstep; u.B = Wq + (size_t)pn * tstep; }
        else { pg8::tile_of(L - 2176, 4, 272, pm, pn); u.A = Wf + (size_t)pm * tstep;
               if (pn < 16) { u.e = 1; u.B = H + (size_t)pn * tstep; }
               else { const int pl = pn - 16, b = pl >> 4, q = pl & 15; u.e = 2; u.B = H + (size_t)(NCTX + b * 4096 + 4 * q) * 2048; } }
        u.pm = pm; u.pn = pn; return true; }
};
struct SchedDft {
    const char* Dm; const char* ZT; int G, c;
    __device__ __forceinline__ bool next(int i, Unit& u) const {
        const int L = i * G + c; if (L >= 512) return false;
        const int pm = L & 15, bp = L >> 4, b = bp >> 1, pn = bp & 1; constexpr size_t tstep = (size_t)256 * 8192 * 2;
        u.pm = pm; u.pn = pn; u.e = b; u.A = Dm + (size_t)pm * tstep; u.B = ZT + (size_t)b * ((size_t)512 * 8192 * 2) + (size_t)pn * tstep; return true; }
};
struct SchedDftC {
    const char* Dm; const char* ZT; int G, c;
    __device__ __forceinline__ bool next(int i, Unit& u) const {
        const int L = i * G + c; if (L >= 32) return false;
        const int b = L >> 1, pn = L & 1;
        u.pm = 0; u.pn = pn; u.e = b; u.A = Dm; u.B = ZT + (size_t)b * ((size_t)512 * 512 * 2) + (size_t)pn * ((size_t)256 * 512 * 2); return true; }
};
struct SchedMoe {
    const char* A; const char* B; const int* tile_e; const int* rowmap; int nT, nN, G, c; size_t strideE;
    __device__ __forceinline__ bool next(int i, Unit& u) const {
        const int L = i * G + c; if (L >= nT * nN) return false;
        int pm, pn; pg8::tile_of(L, nT, nN, pm, pn); constexpr size_t tstep = (size_t)256 * 1024 * 2;
        const int e = __builtin_amdgcn_readfirstlane(tile_e[pm]);
        u.pm = pm; u.pn = pn; u.e = e; u.A = A + (rowmap ? (size_t)0 : (size_t)pm * tstep); u.B = B + (size_t)e * strideE + (size_t)pn * tstep; return true; }
    __device__ __forceinline__ void rowoffs(const Unit& u, const int (&Rl)[2], const int (&Cl)[2], unsigned (&o)[2][2]) const {
#pragma unroll
        for (int h = 0; h < 2; ++h)
#pragma unroll
            for (int i = 0; i < 2; ++i) o[h][i] = (unsigned)rowmap[u.pm * 256 + h * 128 + Rl[i]] * 2048u + (unsigned)Cl[i] * 2u; }
};

struct SchedMoeQ {
    const char* A; const char* B; const LAS int* tab; const int* rlist; int row_pad, nT, nN, G, c; size_t strideE;
    __device__ __forceinline__ bool next(int i, Unit& u) const {
        const int L = i * G + c; if (L >= nT * nN) return false;
        int pm, pn; pg8::tile_of(L, nT, nN, pm, pn); constexpr size_t tstep = (size_t)256 * 1024;
        const int e = __builtin_amdgcn_readfirstlane(tab[pm]);
        u.pm = pm; u.pn = pn; u.e = e; u.A = A + (rlist ? (size_t)0 : (size_t)pm * tstep); u.B = B + (size_t)e * strideE + (size_t)pn * tstep; return true; }
    __device__ __forceinline__ void rowoffs(const Unit& u, int tid, unsigned (&o)[2][2]) const {
        const int cnt = __builtin_amdgcn_readfirstlane(tab[1120 + u.e]), t0 = __builtin_amdgcn_readfirstlane(tab[1152 + u.e]); const int* lst = rlist + (size_t)u.e * MT;
#pragma unroll
        for (int i = 0; i < 2; ++i) { int R, C; pg8::stage_rc(tid * 16 + i * 8192, R, C);
#pragma unroll
            for (int h = 0; h < 2; ++h) { const int idx = (u.pm - t0) * 256 + h * 128 + R; const int row = idx < cnt ? lst[idx] : row_pad; o[h][i] = (unsigned)row * 1024u + (unsigned)C * 2u; } } }
};
__device__ __forceinline__ int moe_tables(Frame& F, int l) {
    LAS int* tab = (LAS int*)(F.lds + LDS_MOE);
    if (F.tid < 32) tab[1120 + F.tid] = (int)__hip_atomic_load(F.ctl + CW_CUR + l * 64 + F.tid, __ATOMIC_RELAXED, __HIP_MEMORY_SCOPE_AGENT);
    __syncthreads();
    if (F.tid == 0) { int t = 0; for (int e = 0; e < 32; ++e) { tab[1152 + e] = t; t += (tab[1120 + e] + 255) >> 8; } tab[1184] = t; }
    __syncthreads();
    const int nT = tab[1184];
    for (int t = F.tid; t < nT; t += 512) { int e = 0;
#pragma unroll 1
        for (int q = 1; q < 32; ++q) e += (tab[1152 + q] <= t) ? 1 : 0;
        tab[t] = e; }
    __syncthreads();
    return __builtin_amdgcn_readfirstlane(nT);
}

__device__ __forceinline__ u32x4 pack8(const f32x4& v0, const f32x4& v1) { u32x4 w; w.x = cvt_pk_bf16(v0[0], v0[1]); w.y = cvt_pk_bf16(v0[2], v0[3]); w.z = cvt_pk_bf16(v1[0], v1[1]); w.w = cvt_pk_bf16(v1[2], v1[3]); return w; }

struct EpiInproj {
    static constexpr bool PERM = true;
    bf16* QKVG; bf16* ZT; bf16* ZTC; const float* rope;
    __device__ __forceinline__ void operator()(AccRef acc, const Unit& u, int wr, int wc, int fr, int fq) const {
        const int row0 = u.pm * 256 + wr * 64 + fr, col0 = u.pn * 256 + wc * 32 + 8 * fq;
        if (u.e == 0) {
            const int kind = u.pn >> 1; const bool lat = u.pm >= 16; const float sc = kind == 0 ? 0.125f : 1.0f; const bool dorope = (kind < 2) && lat;
#pragma unroll
            for (int ai = 0; ai < 2; ++ai) {
                f32x4 rc[4][2];
                if (dorope) {
#pragma unroll
                    for (int m = 0; m < 4; ++m) { const int t = (row0 + ai * 128 + m * 16 - NCTX) & 4095; const int pos = (wc & 1) ? (t & 63) : (t >> 6); const f32x4* rp = (const f32x4*)(rope + pos * 32 + fq * 8); rc[m][0] = rp[0]; rc[m][1] = rp[1]; } }
#pragma unroll
                for (int m = 0; m < 4; ++m) {
                    const int row = row0 + ai * 128 + m * 16;
                    f32x4 cs0 = (f32x4){1.f, 0.f, 1.f, 0.f}, cs1 = cs0;
                    if (dorope) { cs0 = rc[m][0]; cs1 = rc[m][1]; }
                    bf16* rowp = QKVG + (((size_t)(kind * 8 + 4 * (u.pn & 1) + (wc >> 1)) * MT + row) * 64 + 32 * (wc & 1) + 8 * fq);
#pragma unroll
                    for (int bj = 0; bj < 2; ++bj) {
                        f32x4 v0 = acc[ai][bj][m][0] * sc, v1 = acc[ai][bj][m][1] * sc;
                        if (dorope) {
                            f32x4 r0, r1;
                            r0[0] = v0[0] * cs0[0] - v0[1] * cs0[1]; r0[1] = v0[0] * cs0[1] + v0[1] * cs0[0];
                            r0[2] = v0[2] * cs0[2] - v0[3] * cs0[3]; r0[3] = v0[2] * cs0[3] + v0[3] * cs0[2];
                            r1[0] = v1[0] * cs1[0] - v1[1] * cs1[1]; r1[1] = v1[0] * cs1[1] + v1[1] * cs1[0];
                            r1[2] = v1[2] * cs1[2] - v1[3] * cs1[3]; r1[3] = v1[2] * cs1[3] + v1[3] * cs1[2];
                            v0 = r0; v1 = r1; }
                        *(u32x4*)(rowp + (size_t)bj * 2 * MT * 64) = pack8(v0, v1); } } }
        } else {
#pragma unroll
            for (int ai = 0; ai < 2; ++ai)
#pragma unroll
                for (int m = 0; m < 4; ++m) {
                    const int pj = row0 + ai * 128 + m * 16, part = pj >> 9, j = pj & 511;
#pragma unroll
                    for (int bj = 0; bj < 2; ++bj) {
                        const int cc = col0 + bj * 128; bf16* dst;
                        if (u.pn < 16) { const int b = u.pn, t = cc - 256 * b; dst = ZTC + ((size_t)(b * 512 + j) * 512 + part * 256 + t); }
                        else { const int tok = cc - NCTX, b = tok >> 12, t = tok & 4095; dst = ZT + ((size_t)(b * 512 + j) * 8192 + part * 4096 + t); }
                        *(u32x4*)dst = pack8(acc[ai][bj][m][0], acc[ai][bj][m][1]); } }
        }
    }
};
struct EpiCat {
    static constexpr bool PERM = true;
    bf16* CAT; int latent;
    __device__ __forceinline__ void operator()(AccRef acc, const Unit& u, int wr, int wc, int fr, int fq) const {
        const int rowbase = latent ? (NCTX + u.e * 4096) : (u.e * 256);
        const int row0 = rowbase + u.pm * 256 + wr * 64 + fr, col0 = u.pn * 256 + wc * 32 + 8 * fq;
#pragma unroll
        for (int ai = 0; ai < 2; ++ai)
#pragma unroll
            for (int m = 0; m < 4; ++m) { bf16* rowp = CAT + (size_t)(row0 + ai * 128 + m * 16) * 1024 + col0;
#pragma unroll
                for (int bj = 0; bj < 2; ++bj) *(u32x4*)(rowp + bj * 128) = pack8(acc[ai][bj][m][0], acc[ai][bj][m][1]); }
    }
};
struct EpiRes {
    static constexpr bool PERM = true;
    const float* xsrc; const float* csrc; bf16* XB; const float* modv; float* ss; int first;
    __device__ __forceinline__ void operator()(AccRef acc, const Unit& u, int wr, int wc, int fr, int fq) const {
        const int row0 = u.pm * 256 + wr * 64 + fr, col0 = u.pn * 256 + wc * 32 + 8 * fq;
        const bool isctx = u.pm < 16; const int b = isctx ? 16 : ((u.pm - 16) >> 4);
        const float* src = isctx ? csrc : xsrc - (size_t)NCTX * 1024;
        f32x4 gv[2][2];
#pragma unroll
        for (int bj = 0; bj < 2; ++bj)
#pragma unroll
            for (int n = 0; n < 2; ++n) gv[bj][n] = *(const f32x4*)(modv + b * 6144 + 2048 + col0 + bj * 128 + n * 4);
#pragma unroll
        for (int ai = 0; ai < 2; ++ai) {
            float sqs = 0.f;
#pragma unroll
            for (int mb = 0; mb < 4; mb += (ai == 0 ? 2 : 4)) {
                constexpr int NBMAX = 4; const int nb = (ai == 0 ? 2 : 4);
                f32x4 xa[NBMAX][2][2];
#pragma unroll
                for (int q = 0; q < NBMAX; ++q) if (q < nb) { const int m = mb + q; const size_t off = (size_t)(row0 + ai * 128 + m * 16) * 1024 + col0;
#pragma unroll
                    for (int bj = 0; bj < 2; ++bj) {
                        if (first) { xa[q][bj][0] = *(const f32x4*)(src + off + bj * 128); xa[q][bj][1] = *(const f32x4*)(src + off + bj * 128 + 4); }
                        else xa[q][bj][0] = __builtin_bit_cast(f32x4, *(const u32x4*)(XB + off + bj * 128)); } }
#pragma unroll
                for (int q = 0; q < NBMAX; ++q) if (q < nb) { const int m = mb + q; const size_t off = (size_t)(row0 + ai * 128 + m * 16) * 1024 + col0; float sq = 0.f;
#pragma unroll
                    for (int bj = 0; bj < 2; ++bj) { f32x4 x0, x1;
                        if (first) { x0 = xa[q][bj][0]; x1 = xa[q][bj][1]; }
                        else { const u32x4 w = __builtin_bit_cast(u32x4, xa[q][bj][0]); x0 = (f32x4){bf_lo(w.x), bf_hi(w.x), bf_lo(w.y), bf_hi(w.y)}; x1 = (f32x4){bf_lo(w.z), bf_hi(w.z), bf_lo(w.w), bf_hi(w.w)}; }
                        const f32x4 o0 = x0 + gv[bj][0] * acc[ai][bj][m][0], o1 = x1 + gv[bj][1] * acc[ai][bj][m][1];
                        *(u32x4*)(XB + off + bj * 128) = pack8(o0, o1);
                        sq += ((o0[0] * o0[0] + o0[1] * o0[1]) + (o0[2] * o0[2] + o0[3] * o0[3])) + ((o1[0] * o1[0] + o1[1] * o1[1]) + (o1[2] * o1[2] + o1[3] * o1[3])); }
                    { auto s1 = __builtin_amdgcn_permlane16_swap(__float_as_uint(sq), __float_as_uint(sq), false, false); sq = __uint_as_float(s1[0]) + __uint_as_float(s1[1]);
                      auto s2 = __builtin_amdgcn_permlane32_swap(__float_as_uint(sq), __float_as_uint(sq), false, false); sq = __uint_as_float(s2[0]) + __uint_as_float(s2[1]); }
                    sqs = (fq == m) ? sq : sqs; } }
            ss[(size_t)(row0 + ai * 128 + fq * 16) * 16 + u.pn * 4 + wc] = sqs; }
    }
};
struct EpiW1 {
    static constexpr bool PERM = true;
    bf16* ACT; const float* b1;
    __device__ __forceinline__ void operator()(AccRef acc, const Unit& u, int wr, int wc, int fr, int fq) const {
        const int row0 = u.pm * 256 + wr * 64 + fr, a0 = u.pn * 128 + wc * 32 + 8 * fq;
        const f32x4* bp = (const f32x4*)(b1 + u.e * 2048 + 2 * a0);
        const f32x4 q0 = bp[0], q1 = bp[1], q2 = bp[2], q3 = bp[3];
        const f32x4 bg0 = (f32x4){q0[0], q0[2], q1[0], q1[2]}, bl0 = (f32x4){q0[1], q0[3], q1[1], q1[3]};
        const f32x4 bg1 = (f32x4){q2[0], q2[2], q3[0], q3[2]}, bl1 = (f32x4){q2[1], q2[3], q3[1], q3[3]};
#pragma unroll
        for (int ai = 0; ai < 2; ++ai)
#pragma unroll
            for (int m = 0; m < 4; ++m) {
                f32x4 o[2];
#pragma unroll
                for (int n = 0; n < 2; ++n) {
                    const f32x4 g = acc[ai][0][m][n] + (n ? bg1 : bg0), lv = acc[ai][1][m][n] + (n ? bl1 : bl0);
#pragma unroll
                    for (int j = 0; j < 4; ++j) { const float xg = fminf(g[j], 7.0f), xl = fminf(fmaxf(lv[j], -7.0f), 7.0f);
                        const float sg = __builtin_amdgcn_rcpf(1.0f + __builtin_amdgcn_exp2f(-1.702f * 1.4426950408889634f * xg)); o[n][j] = xg * sg * (xl + 1.0f); } }
                *(u32x4*)(ACT + (size_t)(row0 + ai * 128 + m * 16) * 1024 + a0) = pack8(o[0], o[1]); }
    }
};
__device__ __forceinline__ u32x4 widen_pair(u32x2 a, u32x2 b) {
    const auto rx = __builtin_amdgcn_permlane16_swap(a.x, b.x, false, false); const auto ry = __builtin_amdgcn_permlane16_swap(a.y, b.y, false, false);
    u32x4 o; o.x = rx[0]; o.y = ry[0]; o.z = rx[1]; o.w = ry[1]; return o; }
struct EpiW1Q {
    static constexpr bool PERM = true;
    unsigned char* ACT8; const float* b1; const float* cs; float hinv;
    __device__ __forceinline__ const float* sideA(const Unit& u) const { return b1 + u.e * 2048 + u.pn * 256; }
    __device__ __forceinline__ const float* sideB(const Unit& u) const { return cs + u.e * 2048 + u.pn * 256; }
    __device__ __forceinline__ void operator()(AccRef acc, const Unit& u, int wr, int wc, int fr, int fq, const LAS float* side) const {
        const int row0 = u.pm * 256 + wr * 64 + fr, aw = u.pn * 128 + wc * 32 + 16 * (fq >> 1);
        const LAS f32x4* bp = (const LAS f32x4*)(side + 64 * wc + 16 * fq);
        const f32x4 q0 = bp[0], q1 = bp[1], q2 = bp[2], q3 = bp[3];
        const f32x4 bg0 = (f32x4){q0[0], q0[2], q1[0], q1[2]}, bl0 = (f32x4){q0[1], q0[3], q1[1], q1[3]};
        const f32x4 bg1 = (f32x4){q2[0], q2[2], q3[0], q3[2]}, bl1 = (f32x4){q2[1], q2[3], q3[1], q3[3]};
        const float hi = hinv;
        const LAS float* cp = side + 256 + wc * 32 + 8 * fq;
        const f32x4 sg0 = *(const LAS f32x4*)cp * hi, sg1 = *(const LAS f32x4*)(cp + 4) * hi, sl0 = *(const LAS f32x4*)(cp + 128) * hi, sl1 = *(const LAS f32x4*)(cp + 132) * hi;
#pragma unroll
        for (int ai = 0; ai < 2; ++ai) {
            u32x2 w[4];
#pragma unroll
            for (int m = 0; m < 4; ++m) {
                float o[8];
#pragma unroll
                for (int n = 0; n < 2; ++n) {
                    const f32x4 g = acc[ai][0][m][n] * (n ? sg1 : sg0) + (n ? bg1 : bg0), lv = acc[ai][1][m][n] * (n ? sl1 : sl0) + (n ? bl1 : bl0);
#pragma unroll
                    for (int j = 0; j < 4; ++j) { const float xg = fminf(g[j], 7.0f), xl = fminf(fmaxf(lv[j], -7.0f), 7.0f);
                        const float sg = __builtin_amdgcn_rcpf(1.0f + __builtin_amdgcn_exp2f(-1.702f * 1.4426950408889634f * xg)); o[4 * n + j] = (xg * sg) * __builtin_fmaf(xl, 4.0f, 4.0f); } }
                w[m].x = cvt4_fp8(o[0], o[1], o[2], o[3]); w[m].y = cvt4_fp8(o[4], o[5], o[6], o[7]); }
#pragma unroll
            for (int pr = 0; pr < 2; ++pr)
                *(u32x4*)(ACT8 + (size_t)(row0 + ai * 128 + (2 * pr + (fq & 1)) * 16) * 1024 + aw) = widen_pair(w[2 * pr], w[2 * pr + 1]); }
    }
};
struct EpiW2Q {
    static constexpr bool PERM = true;
    unsigned char* EOUT8; unsigned char* ES; const float* b2; const float* cs;
    __device__ __forceinline__ const float* sideA(const Unit& u) const { return b2 + u.e * 1024 + u.pn * 256; }
    __device__ __forceinline__ const float* sideB(const Unit& u) const { return cs + u.e * 1024 + u.pn * 256; }
    __device__ __forceinline__ void operator()(AccRef acc, const Unit& u, int wr, int wc, int fr, int fq, const LAS float* side) const {
        const int row0 = u.pm * 256 + wr * 64 + fr, cw = u.pn * 256 + wc * 32 + 16 * (fq >> 1), lc = wc * 32 + 8 * fq;
        f32x4 bv[2][2], sv[2][2];
#pragma unroll
        for (int bj = 0; bj < 2; ++bj)
#pragma unroll
            for (int n = 0; n < 2; ++n) { bv[bj][n] = *(const LAS f32x4*)(side + lc + bj * 128 + 4 * n); sv[bj][n] = *(const LAS f32x4*)(side + 256 + lc + bj * 128 + 4 * n) * 0.25f; }
#pragma unroll
        for (int ai = 0; ai < 2; ++ai) { unsigned sbw = 0u;
#pragma unroll
            for (int bj = 0; bj < 2; ++bj) { u32x2 w[4];
#pragma unroll
                for (int m = 0; m < 4; ++m) {
                    const f32x4 v0 = acc[ai][bj][m][0] * sv[bj][0] + bv[bj][0], v1 = acc[ai][bj][m][1] * sv[bj][1] + bv[bj][1];
                    float amax = fmaxf(fmaxf(fmaxf(fabsf(v0[0]), fabsf(v0[1])), fmaxf(fabsf(v0[2]), fabsf(v0[3]))), fmaxf(fmaxf(fabsf(v1[0]), fabsf(v1[1])), fmaxf(fabsf(v1[2]), fabsf(v1[3]))));
                    { auto s1 = __builtin_amdgcn_permlane16_swap(__float_as_uint(amax), __float_as_uint(amax), false, false); amax = fmaxf(__uint_as_float(s1[0]), __uint_as_float(s1[1]));
                      auto s2 = __builtin_amdgcn_permlane32_swap(__float_as_uint(amax), __float_as_uint(amax), false, false); amax = fmaxf(__uint_as_float(s2[0]), __uint_as_float(s2[1])); }
                    int sb; float inv; mx_scale(amax, sb, inv);
                    w[m].x = cvt4_fp8(v0[0] * inv, v0[1] * inv, v0[2] * inv, v0[3] * inv); w[m].y = cvt4_fp8(v1[0] * inv, v1[1] * inv, v1[2] * inv, v1[3] * inv);
                    sbw = (fq == m) ? (sbw | ((unsigned)sb << (8 * bj))) : sbw; }
#pragma unroll
                for (int pr = 0; pr < 2; ++pr)
                    *(u32x4*)(EOUT8 + (size_t)(row0 + ai * 128 + (2 * pr + (fq & 1)) * 16) * 1024 + cw + bj * 128) = widen_pair(w[2 * pr], w[2 * pr + 1]); }
            *(unsigned short*)(ES + (size_t)(row0 + ai * 128 + fq * 16) * 32 + u.pn * 8 + wc * 2) = (unsigned short)sbw; }
    }
};
struct EpiW2 {
    static constexpr bool PERM = true;
    bf16* EOUT; const float* b2;
    __device__ __forceinline__ void operator()(AccRef acc, const Unit& u, int wr, int wc, int fr, int fq) const {
        const int row0 = u.pm * 256 + wr * 64 + fr, col0 = u.pn * 256 + wc * 32 + 8 * fq;
        f32x4 bv[2][2];
#pragma unroll
        for (int bj = 0; bj < 2; ++bj)
#pragma unroll
            for (int n = 0; n < 2; ++n) bv[bj][n] = *(const f32x4*)(b2 + u.e * 1024 + col0 + bj * 128 + 4 * n);
#pragma unroll
        for (int ai = 0; ai < 2; ++ai)
#pragma unroll
            for (int m = 0; m < 4; ++m) { bf16* rowp = EOUT + (size_t)(row0 + ai * 128 + m * 16) * 1024 + col0;
#pragma unroll
                for (int bj = 0; bj < 2; ++bj) *(u32x4*)(rowp + bj * 128) = pack8(acc[ai][bj][m][0] + bv[bj][0], acc[ai][bj][m][1] + bv[bj][1]); }
    }
};

template <int KIND>
__device__ __forceinline__ void transpose_item(const float* src, int ld, int k0, int c0, bf16* dst, int Kdst, int drow0, LAS float* scr, int lane) {
#pragma unroll 32
    for (int kk = 0; kk < 64; ++kk) scr[kk * 65 + lane] = src[(size_t)(k0 + kk) * ld + c0 + lane];
    LDS_WAIT();
    const int c = lane & 7;
#pragma unroll
    for (int j = 0; j < 8; ++j) { const int n = (lane >> 3) + 8 * j; const LAS float* s = scr + (8 * c) * 65 + n;
        u32x4 o; o.x = cvt_pk_bf16(s[0 * 65], s[1 * 65]); o.y = cvt_pk_bf16(s[2 * 65], s[3 * 65]); o.z = cvt_pk_bf16(s[4 * 65], s[5 * 65]); o.w = cvt_pk_bf16(s[6 * 65], s[7 * 65]);
        int row;
        if (KIND == 0) row = drow0 + n;
        else if (KIND == 1) row = drow0 + (n < 32 ? 2 * n : 2 * (n - 32) + 1);
        else { const int cs = c0 + n, a = cs >> 1; row = 256 * (a >> 7) + 128 * (cs & 1) + (a & 127); }
        *(u32x4*)(dst + (size_t)row * Kdst + k0 + 8 * c) = o; }
    LDS_WAIT();
}

struct StripDesc { const float* src; int ld, c0; unsigned char* dq; float* dcs; int drow0, kind; };
__device__ __forceinline__ StripDesc strip_desc(const Args& a, unsigned char* ws, int it) {
    StripDesc d;
    if (it < 64 * 32) { const int le = it >> 5, nb = it & 31; d.src = a.in[I_W1] + (size_t)le * 1024 * 2048; d.ld = 2048; d.c0 = nb * 64; d.dq = ws + WS_W1Q + (size_t)le * 2048 * 1024; d.dcs = (float*)(ws + WS_W1CS) + (size_t)le * 2048; d.drow0 = 0; d.kind = 2; }
    else { const int r = it - 64 * 32, le = r >> 4, nb = r & 15; d.src = a.in[I_W2] + (size_t)le * 1024 * 1024; d.ld = 1024; d.c0 = nb * 64; d.dq = ws + WS_W2Q + (size_t)le * 1024 * 1024; d.dcs = (float*)(ws + WS_W2CS) + (size_t)le * 1024; d.drow0 = nb * 64; d.kind = 0; }
    return d;
}
__device__ __forceinline__ void strip_load(const StripDesc& d, int tid, f32x4 (&v)[32]) {
    const int lane = tid & 63, w = tid >> 6, kr = lane >> 4, cg = lane & 15;
#pragma unroll
    for (int i = 0; i < 32; ++i) v[i] = *(const f32x4*)(d.src + (size_t)(w * 128 + 4 * i + kr) * d.ld + d.c0 + 4 * cg);
}
__device__ __forceinline__ void strip_stage(const f32x4 (&v)[32], LAS unsigned char* lds, int tid) {
    LAS bf16* st = (LAS bf16*)lds; LAS float* red = (LAS float*)(lds + 1024 * 68 * 2);
    const int lane = tid & 63, w = tid >> 6, kr = lane >> 4, cg = lane & 15;
    f32x4 am = (f32x4){0.f, 0.f, 0.f, 0.f};
#pragma unroll
    for (int i = 0; i < 32; ++i) { const int k = w * 128 + 4 * i + kr;
        am[0] = fmaxf(am[0], fabsf(v[i][0])); am[1] = fmaxf(am[1], fabsf(v[i][1])); am[2] = fmaxf(am[2], fabsf(v[i][2])); am[3] = fmaxf(am[3], fabsf(v[i][3]));
        u32x2 pw; pw.x = cvt_pk_bf16(v[i][0], v[i][1]); pw.y = cvt_pk_bf16(v[i][2], v[i][3]); *(LAS u32x2*)(st + k * 68 + 4 * cg) = pw; }
#pragma unroll
    for (int e = 0; e < 4; ++e) { am[e] = fmaxf(am[e], __shfl_xor(am[e], 16)); am[e] = fmaxf(am[e], __shfl_xor(am[e], 32)); }
    if (kr == 0) *(LAS f32x4*)(red + w * 64 + 4 * cg) = am;
}
__device__ __forceinline__ void strip_quant(const StripDesc& d, LAS unsigned char* lds, int tid) {
    LAS bf16* st = (LAS bf16*)lds; LAS float* red = (LAS float*)(lds + 1024 * 68 * 2);
    const int n = tid >> 3, kq = tid & 7;
    float cm = 0.f;
#pragma unroll
    for (int i = 0; i < 8; ++i) cm = fmaxf(cm, red[i * 64 + n]);
    int sb; float inv; mx_scale(cm, sb, inv);
    int row;
    if (d.kind == 0) row = d.drow0 + n; else { const int cs_ = d.c0 + n, a = cs_ >> 1; row = 256 * (a >> 7) + 128 * (cs_ & 1) + (a & 127); }
#pragma unroll 2
    for (int i = 0; i < 8; ++i) { const int k0 = 128 * i + 16 * kq; float v[16];
#pragma unroll
        for (int e = 0; e < 16; ++e) v[e] = bf2f(st[(k0 + e) * 68 + n]) * inv;
        u32x4 o; o.x = cvt4_fp8(v[0], v[1], v[2], v[3]); o.y = cvt4_fp8(v[4], v[5], v[6], v[7]); o.z = cvt4_fp8(v[8], v[9], v[10], v[11]); o.w = cvt4_fp8(v[12], v[13], v[14], v[15]);
        *(u32x4*)(d.dq + (size_t)row * 1024 + k0) = o; }
    if (kq == 0) d.dcs[row] = __uint_as_float((unsigned)sb << 23);
}

__device__ __forceinline__ void p0_prologue(Frame& F, const Args& a) {
    const int gw = F.c * 8 + F.wave, NGW = F.G * 8, lane = F.lane;
    { LAS float* siluT = (LAS float*)F.lds;
      for (int i = F.tid; i < 17 * 1024; i += 512) { const int r = i >> 10, k = i & 1023; const float v = r < 16 ? a.in[I_C][r * 1024 + k] : a.in[I_CCTX][k]; siluT[i] = v / (1.0f + __expf(-v)); }
      __syncthreads();
      float* modp = (float*)(F.ws + WS_MODP);
      for (int it = gw; it < 192 * 16; it += NGW) {
          const int cg = it % 192, ks = it / 192, col = cg * 64 + lane, l = col / 6144, cc = col - l * 6144;
          const float* wp = a.in[I_MODW] + ((size_t)l * 1024 + ks * 64) * 6144 + cc;
          float wv[64];
#pragma unroll
          for (int k = 0; k < 64; ++k) wv[k] = wp[(size_t)k * 6144];
          float acc[17];
#pragma unroll
          for (int r = 0; r < 17; ++r) acc[r] = 0.f;
#pragma unroll
          for (int k = 0; k < 64; ++k) {
#pragma unroll
              for (int r = 0; r < 17; ++r) acc[r] += siluT[r * 1024 + ks * 64 + k] * wv[k]; }
#pragma unroll
          for (int r = 0; r < 17; ++r) modp[(size_t)(ks * 17 + r) * 12288 + col] = acc[r];
      }
      __syncthreads(); }
    SUBSTAMP(F, 0, 5);
    { LAS f32x2* tab = (LAS f32x2*)F.lds;
      for (int i = F.tid; i < 4096; i += 512) { float s, c; sincospif((float)i * (1.0f / 2048.0f), &s, &c); tab[i] = (f32x2){c, s}; }
      __syncthreads();
      bf16* dftc = (bf16*)(F.ws + WS_DFTC);
      for (int it = gw; it < 256; it += NGW) {
          { const int tp = it, k8 = lane * 8; float v[8];
#pragma unroll
              for (int e = 0; e < 8; ++e) { const int kk = k8 + e, part = kk >> 8, t = kk & 255; const f32x2 cs = tab[((t * tp) & 255) * 16]; v[e] = (part ? -cs.y : cs.x) * (1.0f / 16.0f); }
              u32x4 o; o.x = cvt_pk_bf16(v[0], v[1]); o.y = cvt_pk_bf16(v[2], v[3]); o.z = cvt_pk_bf16(v[4], v[5]); o.w = cvt_pk_bf16(v[6], v[7]);
              *(u32x4*)(dftc + (size_t)tp * 512 + k8) = o; } }
      bf16* wf = (bf16*)(F.ws + WS_WF);
      for (int it = gw; it < 2 * 8 * 128; it += NGW) {
          const int l = it >> 10, g = (it >> 7) & 7, k8 = it & 127;
          float xin[8], ac[8], as[8];
#pragma unroll
          for (int kk = 0; kk < 8; ++kk) { xin[kk] = a.in[I_WIN][((size_t)l * 1024 + k8 * 8 + kk) * 2560 + g * 64 + lane]; ac[kk] = 0.f; as[kk] = 0.f; }
          for (int cidx = 0; cidx < 64; ++cidx) { const f32x2 cs = tab[((cidx * lane) & 63) * 64];
#pragma unroll
              for (int kk = 0; kk < 8; ++kk) { const float v = __shfl(xin[kk], cidx); ac[kk] += v * cs.x; as[kk] += v * cs.y; } }
          u32x4 oc, os;
          oc.x = cvt_pk_bf16(ac[0] * 0.125f, ac[1] * 0.125f); oc.y = cvt_pk_bf16(ac[2] * 0.125f, ac[3] * 0.125f); oc.z = cvt_pk_bf16(ac[4] * 0.125f, ac[5] * 0.125f); oc.w = cvt_pk_bf16(ac[6] * 0.125f, ac[7] * 0.125f);
          os.x = cvt_pk_bf16(as[0] * 0.125f, as[1] * 0.125f); os.y = cvt_pk_bf16(as[2] * 0.125f, as[3] * 0.125f); os.z = cvt_pk_bf16(as[4] * 0.125f, as[5] * 0.125f); os.w = cvt_pk_bf16(as[6] * 0.125f, as[7] * 0.125f);
          *(u32x4*)(wf + ((size_t)l * 1024 + g * 64 + lane) * 1024 + k8 * 8) = oc;
          *(u32x4*)(wf + ((size_t)l * 1024 + 512 + g * 64 + lane) * 1024 + k8 * 8) = os; }
      if (F.c == 0) { float* rope = (float*)(F.ws + WS_ROPE);
          for (int i = F.tid; i < 64 * 16; i += 512) { const int pos = i >> 4, f = i & 15; const float fr = powf(10000.0f, -(float)f / 16.0f); const float ang = (float)pos * fr; rope[i * 2] = cosf(ang); rope[i * 2 + 1] = sinf(ang); } }
      __syncthreads(); }
    SUBSTAMP(F, 0, 6);
    { LAS float* scr = (LAS float*)(F.lds + F.wave * 16640);
      constexpr int N_IN = 2 * 16 * 32, N_OUT = 2 * 16 * 16, NITEMS = N_IN + N_OUT;
      for (int it = gw; it < NITEMS; it += NGW) {
          int r = it;
          if (r < N_IN) { const int l = r >> 9, kb = (r >> 5) & 15, nb = r & 31; const float* src = a.in[I_WIN] + (size_t)l * 1024 * 2560; bf16* dst = (bf16*)(F.ws + WS_WQ) + (size_t)l * 2048 * 1024;
              if (nb < 16) transpose_item<1>(src, 2560, kb * 64, 512 + nb * 64, dst, 1024, nb * 64, scr, lane);
              else transpose_item<0>(src, 2560, kb * 64, 512 + nb * 64, dst, 1024, nb * 64, scr, lane);
              continue; }
          r -= N_IN;
          { const int l = r >> 8, kb = (r >> 4) & 15, nb = r & 15;
            transpose_item<0>(a.in[I_WOUT] + (size_t)l * 1024 * 1024, 1024, kb * 64, nb * 64, (bf16*)(F.ws + WS_WO) + (size_t)l * 1024 * 1024, 1024, nb * 64, scr, lane); }
      } }
    __syncthreads();
    SUBSTAMP(F, 0, 7);
    { constexpr int NSTRIP = 64 * 32 + 64 * 16; int it = F.c; f32x4 sv[32];
      if (it < NSTRIP) { const StripDesc d = strip_desc(a, F.ws, it); strip_load(d, F.tid, sv); }
      while (it < NSTRIP) {
          strip_stage(sv, F.lds, F.tid);
          __syncthreads();
          const int itn = it + F.G;
          if (itn < NSTRIP) { const StripDesc dn = strip_desc(a, F.ws, itn); strip_load(dn, F.tid, sv); }
          { const StripDesc d = strip_desc(a, F.ws, it); strip_quant(d, F.lds, F.tid); }
          __syncthreads();
          it = itn; } }
}

__device__ __forceinline__ float mod_sum(const float* modp, const float* modb, int l, int r, int cc) {
    float s = modb[l * 6144 + cc];
#pragma unroll
    for (int ks = 0; ks < 16; ++ks) s += modp[(size_t)(ks * 17 + r) * 12288 + l * 6144 + cc];
    return s;
}
__device__ __forceinline__ void p0b_finalize(Frame& F, const Args& a) {
    const float* modp = (const float*)(F.ws + WS_MODP); float* modv = (float*)(F.ws + WS_MODV); float* a12 = (float*)(F.ws + WS_A12);
    const int gt = F.c * 512 + F.tid, NT = F.G * 512;
    for (int i = gt; i < 2 * 17 * 6144; i += NT) { const int l = i / (17 * 6144), rem = i - l * 17 * 6144, r = rem / 6144, cc = rem - r * 6144; modv[i] = mod_sum(modp, a.in[I_MODB], l, r, cc); }
    for (int i = gt; i < 2 * 2 * 17 * 1024; i += NT) { const int k = i & 1023, r = (i >> 10) % 17, w = ((i >> 10) / 17) & 1, l = (i >> 10) / 34;
        a12[i] = a.in[I_NORMW][(l * 2 + w) * 1024 + k] * (1.0f + mod_sum(modp, a.in[I_MODB], l, r, (w ? 4096 : 1024) + k)); }
}

__device__ __forceinline__ void p1_router_tables(Frame& F, const Args& a) {
    const int gt = F.c * 512 + F.tid, NT = F.G * 512;
    for (int i = gt; i < 2 * 32 * 2 * 64; i += NT) { const int ln = i & 63, et = (i >> 6) & 1, ks = (i >> 7) & 31, l = i >> 12; float hi[8], lo[8];
        const float* rwp = a.in[I_RW] + (size_t)l * 1024 * 32;
#pragma unroll
        for (int e = 0; e < 8; ++e) { const float wv = rwp[(size_t)(32 * ks + 8 * (ln >> 4) + e) * 32 + 16 * et + (ln & 15)]; const unsigned hb = cvt_pk_bf16(wv, 0.f) & 0xffffu; hi[e] = __uint_as_float(hb << 16); lo[e] = wv - hi[e]; }
        u32x4 wh, wl; wh.x = cvt_pk_bf16(hi[0], hi[1]); wh.y = cvt_pk_bf16(hi[2], hi[3]); wh.z = cvt_pk_bf16(hi[4], hi[5]); wh.w = cvt_pk_bf16(hi[6], hi[7]);
        wl.x = cvt_pk_bf16(lo[0], lo[1]); wl.y = cvt_pk_bf16(lo[2], lo[3]); wl.z = cvt_pk_bf16(lo[4], lo[5]); wl.w = cvt_pk_bf16(lo[6], lo[7]);
        unsigned char* rt = F.ws + WS_RT + (size_t)l * 131072;
        *(u32x4*)(rt + ((ks * 2 + et) * 2 + 0) * 1024 + ln * 16) = wh; *(u32x4*)(rt + ((ks * 2 + et) * 2 + 1) * 1024 + ln * 16) = wl; }
    if (F.c < 2) { const int l = F.c;
        const float* a12l = (const float*)(F.ws + WS_A12) + (size_t)(l * 2 + 1) * 17 * 1024; const float* modl = (const float*)(F.ws + WS_MODV) + (size_t)l * 17 * 6144;
        float gm = 0.f, sm = 0.f;
        for (int i = F.tid; i < 17 * 1024; i += 512) { gm = fmaxf(gm, fabsf(a12l[i])); sm = fmaxf(sm, fabsf(modl[(size_t)(i >> 10) * 6144 + 3072 + (i & 1023)])); }
#pragma unroll
        for (int o = 1; o < 64; o <<= 1) { gm = fmaxf(gm, __shfl_xor(gm, o)); sm = fmaxf(sm, __shfl_xor(sm, o)); }
        LAS float* rd = (LAS float*)F.lds;
        if (F.lane == 0) { rd[F.wave * 2] = gm; rd[F.wave * 2 + 1] = sm; }
        __syncthreads();
        if (F.tid == 0) { gm = 0.f; sm = 0.f; for (int i = 0; i < 8; ++i) { gm = fmaxf(gm, rd[2 * i]); sm = fmaxf(sm, rd[2 * i + 1]); }
            int sb; float inv; mx_scale(32.0f * gm + sm, sb, inv); float* hs = (float*)(F.ws + WS_HSC) + l * 2; hs[0] = inv; hs[1] = __uint_as_float((unsigned)sb << 23); }
        __syncthreads(); }
}
__device__ __forceinline__ void p1_norm1_layer0(Frame& F, const Args& a) {
    const int gw = F.c * 8 + F.wave, NGW = F.G * 8, lane = F.lane; constexpr int NR = 4;
    const float* a12 = (const float*)(F.ws + WS_A12); const float* modv = (const float*)(F.ws + WS_MODV); bf16* H = (bf16*)(F.ws + WS_H);
    for (int r0 = gw * NR; r0 < MT; r0 += NGW * NR) {
        const int b = batch_of_row(r0);
        f32x4 v[NR][4], g[4], sh[4];
#pragma unroll
        for (int q = 0; q < NR; ++q) { const int r = r0 + q; const float* xrow = r < NCTX ? a.in[I_CTX] + (size_t)r * 1024 : a.in[I_X] + (size_t)(r - NCTX) * 1024;
#pragma unroll
            for (int j = 0; j < 4; ++j) v[q][j] = ((const f32x4*)xrow)[lane + 64 * j]; }
#pragma unroll
        for (int j = 0; j < 4; ++j) { g[j] = ((const f32x4*)(a12 + (size_t)b * 1024))[lane + 64 * j]; sh[j] = ((const f32x4*)(modv + (size_t)b * 6144))[lane + 64 * j]; }
#pragma unroll
        for (int q = 0; q < NR; ++q) { float ss = 0.f;
#pragma unroll
            for (int j = 0; j < 4; ++j) ss += (v[q][j][0] * v[q][j][0] + v[q][j][1] * v[q][j][1]) + (v[q][j][2] * v[q][j][2] + v[q][j][3] * v[q][j][3]);
            const float rn = rsqrtf(wave_sum(ss) * (1.0f / 1024.0f) + NORM_EPS);
#pragma unroll
            for (int j = 0; j < 4; ++j) { const f32x4 h = v[q][j] * rn * g[j] + sh[j]; u32x2 w; w.x = cvt_pk_bf16(h[0], h[1]); w.y = cvt_pk_bf16(h[2], h[3]); ((u32x2*)(H + (size_t)(r0 + q) * 1024))[lane + 64 * j] = w; } }
    }
}

typedef short v4i16_t __attribute__((ext_vector_type(4)));
__device__ __forceinline__ bf16x8 tr8(const LAS bf16* p, int rs4) {
    const v4i16_t lo = __builtin_amdgcn_ds_read_tr16_b64_v4i16((LAS v4i16_t*)p), hi = __builtin_amdgcn_ds_read_tr16_b64_v4i16((LAS v4i16_t*)(p + rs4));
    return (bf16x8){lo[0], lo[1], lo[2], lo[3], hi[0], hi[1], hi[2], hi[3]};
}
__device__ __forceinline__ void retention_phase(Frame& F, const Args& a, int l) {
    constexpr int QS = 72, TS = 136, SS = 72;
    constexpr int O_Q = 0, O_K = 18432, O_KW = 36864, O_V = 55296, O_P = 73728, O_ST = 108544;
    LAS bf16* Qs = (LAS bf16*)(F.lds + O_Q); LAS bf16* Ks = (LAS bf16*)(F.lds + O_K); LAS bf16* Kw = (LAS bf16*)(F.lds + O_KW); LAS bf16* Vs = (LAS bf16*)(F.lds + O_V);
    LAS bf16* Ps = (LAS bf16*)(F.lds + O_P); LAS bf16* ST = (LAS bf16*)(F.lds + O_ST);
    const bf16* QKVG = (const bf16*)(F.ws + WS_QKVG);
    const int tid = F.tid, lane = F.lane, w = F.wave, lr = lane & 15, lq = lane >> 4;
    const int troff = (8 * lq + (lr >> 2)) * QS + 4 * (lr & 3);
    for (int unit = F.c; unit < 256; unit += F.G) {
        const int dir = unit & 1, h = (unit >> 1) & 7, b = unit >> 4;
        bf16* OUT = (bf16*)(F.ws + (dir ? WS_OB : WS_OF));
        const float rd = a.in[I_DECAY][l * 16 + dir * 8 + h];
        const float lg2 = log1pf(-exp2f(-rd)) * 1.4426950408889634f;
        const int il = 16 * w + lr;
        float mask[8][4];
#pragma unroll
        for (int jt = 0; jt < 8; ++jt)
#pragma unroll
            for (int r = 0; r < 4; ++r) { const int j = 16 * jt + 4 * lq + r; mask[jt][r] = (j <= il) ? exp2f((float)(il - j) * lg2) : 0.0f; }
        const float wq = exp2f((float)(il + 1) * lg2), gch = exp2f(128.0f * lg2);
        const int ldr = tid >> 2, ldq = tid & 3;
        const float wkv = exp2f((float)(127 - ldr) * lg2);
        f32x4 Sacc[2] = {(f32x4){0.f, 0.f, 0.f, 0.f}, (f32x4){0.f, 0.f, 0.f, 0.f}};
        const int tm = w >> 1, tn0 = 2 * (w & 1);
        for (int i = tid; i < 64 * SS / 2; i += 512) ((LAS unsigned*)ST)[i] = 0u;
        u32x4 pq[2], pk[2], pv[2];
        auto chunk_base = [&](int s) -> int { if (s < 2) return b * 256 + 128 * (dir ? 1 - s : s); return NCTX + b * 4096 + 128 * (dir ? 31 - (s - 2) : (s - 2)); };
        { const int gr = chunk_base(0) + (dir ? 127 - ldr : ldr); const bf16* p = QKVG + ((size_t)h * MT + gr) * 64 + ldq * 16; constexpr size_t TSTR = (size_t)8 * MT * 64;
          pq[0] = *(const u32x4*)p; pq[1] = *(const u32x4*)(p + 8); pk[0] = *(const u32x4*)(p + TSTR); pk[1] = *(const u32x4*)(p + TSTR + 8); pv[0] = *(const u32x4*)(p + 2 * TSTR); pv[1] = *(const u32x4*)(p + 2 * TSTR + 8); }
        for (int s = 0; s < 34; ++s) {
            const int cb = chunk_base(s);
            { const int o = ldr * QS + ldq * 16;
              *(LAS u32x4*)(Qs + o) = pq[0]; *(LAS u32x4*)(Qs + o + 8) = pq[1]; *(LAS u32x4*)(Ks + o) = pk[0]; *(LAS u32x4*)(Ks + o + 8) = pk[1]; *(LAS u32x4*)(Vs + o) = pv[0]; *(LAS u32x4*)(Vs + o + 8) = pv[1];
              u32x4 kw0, kw1;
              kw0.x = cvt_pk_bf16(bf_lo(pk[0].x) * wkv, bf_hi(pk[0].x) * wkv); kw0.y = cvt_pk_bf16(bf_lo(pk[0].y) * wkv, bf_hi(pk[0].y) * wkv); kw0.z = cvt_pk_bf16(bf_lo(pk[0].z) * wkv, bf_hi(pk[0].z) * wkv); kw0.w = cvt_pk_bf16(bf_lo(pk[0].w) * wkv, bf_hi(pk[0].w) * wkv);
              kw1.x = cvt_pk_bf16(bf_lo(pk[1].x) * wkv, bf_hi(pk[1].x) * wkv); kw1.y = cvt_pk_bf16(bf_lo(pk[1].y) * wkv, bf_hi(pk[1].y) * wkv); kw1.z = cvt_pk_bf16(bf_lo(pk[1].z) * wkv, bf_hi(pk[1].z) * wkv); kw1.w = cvt_pk_bf16(bf_lo(pk[1].w) * wkv, bf_hi(pk[1].w) * wkv);
              *(LAS u32x4*)(Kw + o) = kw0; *(LAS u32x4*)(Kw + o + 8) = kw1; }
            __syncthreads();
            if (s + 1 < 34) { const int gr = chunk_base(s + 1) + (dir ? 127 - ldr : ldr); const bf16* p = QKVG + ((size_t)h * MT + gr) * 64 + ldq * 16; constexpr size_t TSTR = (size_t)8 * MT * 64;
                pq[0] = *(const u32x4*)p; pq[1] = *(const u32x4*)(p + 8); pk[0] = *(const u32x4*)(p + TSTR); pk[1] = *(const u32x4*)(p + TSTR + 8); pv[0] = *(const u32x4*)(p + 2 * TSTR); pv[1] = *(const u32x4*)(p + 2 * TSTR + 8); }
            bf16x8 bq[2];
#pragma unroll
            for (int ks = 0; ks < 2; ++ks) bq[ks] = *(const LAS bf16x8*)(Qs + (16 * w + lr) * QS + 32 * ks + 8 * lq);
#pragma unroll
            for (int jt = 0; jt < 8; ++jt) {
                if (jt <= w) {
                    f32x4 p = (f32x4){0.f, 0.f, 0.f, 0.f};
#pragma unroll
                    for (int ks = 0; ks < 2; ++ks) { const bf16x8 ak = *(const LAS bf16x8*)(Ks + (16 * jt + lr) * QS + 32 * ks + 8 * lq); p = __builtin_amdgcn_mfma_f32_16x16x32_bf16(ak, bq[ks], p, 0, 0, 0); }
                    u32x2 pw; pw.x = cvt_pk_bf16(p[0] * mask[jt][0], p[1] * mask[jt][1]); pw.y = cvt_pk_bf16(p[2] * mask[jt][2], p[3] * mask[jt][3]);
                    *(LAS u32x2*)(Ps + (16 * w + lr) * TS + 16 * jt + 4 * lq) = pw;
                } else if (jt == w + 1) { u32x2 pz; pz.x = 0u; pz.y = 0u; *(LAS u32x2*)(Ps + (16 * w + lr) * TS + 16 * jt + 4 * lq) = pz; } }
            LDS_WAIT();
            f32x4 oacc[4], cacc[4];
#pragma unroll
            for (int tn = 0; tn < 4; ++tn) { oacc[tn] = (f32x4){0.f, 0.f, 0.f, 0.f}; cacc[tn] = (f32x4){0.f, 0.f, 0.f, 0.f}; }
#pragma unroll
            for (int ks = 0; ks < 4; ++ks) if (2 * ks <= w) { const bf16x8 bp = *(const LAS bf16x8*)(Ps + (16 * w + lr) * TS + 32 * ks + 8 * lq);
#pragma unroll
                for (int tn = 0; tn < 4; ++tn) { const bf16x8 av = tr8(Vs + troff + 32 * ks * QS + 16 * tn, 4 * QS); oacc[tn] = __builtin_amdgcn_mfma_f32_16x16x32_bf16(av, bp, oacc[tn], 0, 0, 0); } }
#pragma unroll
            for (int ks = 0; ks < 2; ++ks)
#pragma unroll
                for (int tn = 0; tn < 4; ++tn) { const bf16x8 as_ = *(const LAS bf16x8*)(ST + (16 * tn + lr) * SS + 32 * ks + 8 * lq); cacc[tn] = __builtin_amdgcn_mfma_f32_16x16x32_bf16(as_, bq[ks], cacc[tn], 0, 0, 0); }
            { const int gr = cb + (dir ? 127 - il : il); bf16* op = OUT + ((size_t)h * MT + gr) * 64 + 4 * lq;
#pragma unroll
              for (int tn = 0; tn < 4; ++tn) { const f32x4 o = oacc[tn] + cacc[tn] * wq; u32x2 ow; ow.x = cvt_pk_bf16(o[0], o[1]); ow.y = cvt_pk_bf16(o[2], o[3]); *(u32x2*)(op + 16 * tn) = ow; } }
            f32x4 sn[2] = {(f32x4){0.f, 0.f, 0.f, 0.f}, (f32x4){0.f, 0.f, 0.f, 0.f}};
#pragma unroll
            for (int ks = 0; ks < 4; ++ks) { const bf16x8 ak = tr8(Kw + troff + 32 * ks * QS + 16 * tm, 4 * QS);
#pragma unroll
                for (int q = 0; q < 2; ++q) { const bf16x8 bv = tr8(Vs + troff + 32 * ks * QS + 16 * (tn0 + q), 4 * QS); sn[q] = __builtin_amdgcn_mfma_f32_16x16x32_bf16(ak, bv, sn[q], 0, 0, 0); } }
#pragma unroll
            for (int q = 0; q < 2; ++q) Sacc[q] = Sacc[q] * gch + sn[q];
            __syncthreads();
#pragma unroll
            for (int q = 0; q < 2; ++q) { u32x2 sw; sw.x = cvt_pk_bf16(Sacc[q][0], Sacc[q][1]); sw.y = cvt_pk_bf16(Sacc[q][2], Sacc[q][3]); *(LAS u32x2*)(ST + (16 * (tn0 + q) + lr) * SS + 16 * tm + 4 * lq) = sw; }
        }
        __syncthreads();
    }
}

__device__ __forceinline__ void merge_phase(Frame& F, const Args& a, int l) {
    const bool skew = (l == 0 && F.G == 256); if (skew && F.c < 32) return;
    const int gw = (skew ? F.c - 32 : F.c) * 8 + F.wave, NGW = (skew ? F.G - 32 : F.G) * 8, lane = F.lane; constexpr int NR = 4;
    const bf16* OFp = (const bf16*)(F.ws + WS_OF); const bf16* OBp = (const bf16*)(F.ws + WS_OB); const bf16* QKVG = (const bf16*)(F.ws + WS_QKVG); bf16* CAT = (bf16*)(F.ws + WS_CAT);
    const float* rw = a.in[I_RNW] + l * 512 + lane * 8;
    const f32x4 w0 = *(const f32x4*)rw, w1 = *(const f32x4*)(rw + 4);
    for (int r0 = (l ? NCTX : 0) + gw * NR; r0 < MT; r0 += NGW * NR) {
        u32x4 fv[NR], bv[NR], gv[NR];
#pragma unroll
        for (int q = 0; q < NR; ++q) { const size_t r = r0 + q, ho = ((size_t)(lane >> 3) * MT + r) * 64 + 8 * (lane & 7); fv[q] = *(const u32x4*)(OFp + ho); bv[q] = *(const u32x4*)(OBp + ho); gv[q] = *(const u32x4*)(QKVG + (size_t)24 * MT * 64 + ho); }
#pragma unroll
        for (int q = 0; q < NR; ++q) {
            float o[8]; const unsigned fw[4] = {fv[q].x, fv[q].y, fv[q].z, fv[q].w}, bw[4] = {bv[q].x, bv[q].y, bv[q].z, bv[q].w}, gwd[4] = {gv[q].x, gv[q].y, gv[q].z, gv[q].w};
            float sm = 0.f;
#pragma unroll
            for (int e = 0; e < 4; ++e) { o[2 * e] = bf_lo(fw[e]) + bf_lo(bw[e]); o[2 * e + 1] = bf_hi(fw[e]) + bf_hi(bw[e]); sm += o[2 * e] + o[2 * e + 1]; }
            sm += __shfl_xor(sm, 1); sm += __shfl_xor(sm, 2); sm += __shfl_xor(sm, 4);
            const float mu = sm * (1.0f / 64.0f); float qv = 0.f;
#pragma unroll
            for (int e = 0; e < 8; ++e) { o[e] -= mu; qv += o[e] * o[e]; }
            qv += __shfl_xor(qv, 1); qv += __shfl_xor(qv, 2); qv += __shfl_xor(qv, 4);
            const float rs = rsqrtf(qv * (1.0f / 64.0f) + NORM_EPS);
            float y[8];
#pragma unroll
            for (int e = 0; e < 4; ++e) { const float g0 = bf_lo(gwd[e]), g1 = bf_hi(gwd[e]);
                y[2 * e] = g0 / (1.0f + __expf(-g0)) * o[2 * e] * rs; y[2 * e + 1] = g1 / (1.0f + __expf(-g1)) * o[2 * e + 1] * rs; }
            u32x4 ow; ow.x = cvt_pk_bf16(y[0] * w0[0], y[1] * w0[1]); ow.y = cvt_pk_bf16(y[2] * w0[2], y[3] * w0[3]); ow.z = cvt_pk_bf16(y[4] * w1[0], y[5] * w1[1]); ow.w = cvt_pk_bf16(y[6] * w1[2], y[7] * w1[3]);
            *(u32x4*)(CAT + (size_t)(r0 + q) * 1024 + 512 + lane * 8) = ow; }
    }
}

__device__ __forceinline__ void fft_phase(Frame& F) {
    LAS unsigned char* B1 = F.lds; LAS unsigned char* B2 = F.lds + 32768; LAS bf16* Yall = (LAS bf16*)(F.lds + 49152); LAS bf16* Yw = Yall + F.wave * 4352;
    const int tid = F.tid, lane = F.lane, lr = lane & 15, lq = lane >> 4;
    for (int idx = tid; idx < 48 * 64; idx += 512) {
        const int fi = idx >> 6, ln = idx & 63; float v[8];
        if (fi < 32) { const int nt = fi >> 2, ks = fi & 3, pp = nt >> 2, rp = 16 * (nt & 3) + (ln & 15);
#pragma unroll
            for (int e = 0; e < 8; ++e) { const int k = 32 * ks + 8 * (ln >> 4) + e, pk = k >> 6, r = k & 63; float sn, cs; sincospif((float)((r * rp) & 63) * (1.0f / 32.0f), &sn, &cs);
                v[e] = 0.125f * ((pp == 0 && pk == 0) ? cs : ((pp == 1 && pk == 1) ? -cs : -sn)); } }
        else { const int f2 = fi - 32, ks2 = f2 >> 2, st = f2 & 3, sp = 16 * st + (ln & 15), pp = ks2 >> 1, stp = ks2 & 1;
#pragma unroll
            for (int e = 0; e < 8; ++e) { const int sidx = 16 * (2 * stp + (e >> 2)) + 4 * (ln >> 4) + (e & 3); float sn, cs; sincospif((float)((sidx * sp) & 63) * (1.0f / 32.0f), &sn, &cs);
                v[e] = 0.125f * (pp ? sn : cs); } }
        u32x4 o; o.x = cvt_pk_bf16(v[0], v[1]); o.y = cvt_pk_bf16(v[2], v[3]); o.z = cvt_pk_bf16(v[4], v[5]); o.w = cvt_pk_bf16(v[6], v[7]);
        *(LAS u32x4*)(F.lds + fi * 1024 + ln * 16) = o; }
    __syncthreads();
    SUBSTAMP(F, 0, 4);
    const bf16* ZT = (const bf16*)(F.ws + WS_ZT); bf16* CAT = (bf16*)(F.ws + WS_CAT);
    auto grp_of = [&](int git) -> int { int grp = git;
        if (F.G == 256) { const int it = git >> 8, c = git & 255, xcd = c & 7, i = c >> 3, k = (it * 4 + (i >> 3)) * 8 + xcd; grp = (k >> 3) * 64 + (k & 7) * 8 + (i & 7); }
        return grp; };
    bf16x8 a1[4][4];
    auto load_col = [&](int git) { const int grp = grp_of(git), b = grp >> 6, jg = grp & 63, j = jg * 8 + F.wave; const bf16* col = ZT + (size_t)(b * 512 + j) * 8192;
#pragma unroll
        for (int mt = 0; mt < 4; ++mt)
#pragma unroll
            for (int ks = 0; ks < 4; ++ks) a1[mt][ks] = *(const bf16x8*)(col + (ks >> 1) * 4096 + (16 * mt + lr) * 64 + 32 * (ks & 1) + 8 * lq); };
    if (F.c < 1024) load_col(F.c);
    for (int git = F.c; git < 1024; git += F.G) {
        const int grp = grp_of(git);
        const int b = grp >> 6, jg = grp & 63;
        const int gnext = (git + F.G < 1024) ? git + F.G : git;
#pragma unroll 1
        for (int rb = 0; rb < 4; ++rb) {
            f32x4 ur[4], ui[4];
#pragma unroll
            for (int mt = 0; mt < 4; ++mt) { ur[mt] = (f32x4){0.f, 0.f, 0.f, 0.f}; ui[mt] = (f32x4){0.f, 0.f, 0.f, 0.f}; }
#pragma unroll
            for (int ks = 0; ks < 4; ++ks) { const bf16x8 b1r = *(const LAS bf16x8*)(B1 + (rb * 4 + ks) * 1024 + lane * 16), b1i = *(const LAS bf16x8*)(B1 + ((rb + 4) * 4 + ks) * 1024 + lane * 16);
#pragma unroll
                for (int mt = 0; mt < 4; ++mt) { ur[mt] = __builtin_amdgcn_mfma_f32_16x16x32_bf16(a1[mt][ks], b1r, ur[mt], 0, 0, 0); ui[mt] = __builtin_amdgcn_mfma_f32_16x16x32_bf16(a1[mt][ks], b1i, ui[mt], 0, 0, 0); } }
            if (rb == 3) load_col(gnext);
            const int rp = 16 * rb + lr;
#pragma unroll
            for (int mt = 0; mt < 4; ++mt)
#pragma unroll
                for (int r = 0; r < 4; ++r) { const int sidx = 16 * mt + 4 * lq + r; const float x = (float)((sidx * rp) & 4095) * (1.0f / 4096.0f);
                    const float c = __builtin_amdgcn_cosf(x), sn = __builtin_amdgcn_sinf(x); const float tr = ur[mt][r] * c + ui[mt][r] * sn, ti = ui[mt][r] * c - ur[mt][r] * sn; ur[mt][r] = tr; ui[mt][r] = ti; }
            bf16x8 a2[4];
#pragma unroll
            for (int ks2 = 0; ks2 < 4; ++ks2) { const int stp = ks2 & 1; const f32x4 lo = (ks2 >> 1) ? ui[2 * stp] : ur[2 * stp], hi = (ks2 >> 1) ? ui[2 * stp + 1] : ur[2 * stp + 1];
                a2[ks2] = __builtin_bit_cast(bf16x8, pack8(lo, hi)); }
            f32x4 y[4];
#pragma unroll
            for (int st = 0; st < 4; ++st) y[st] = (f32x4){0.f, 0.f, 0.f, 0.f};
#pragma unroll
            for (int ks2 = 0; ks2 < 4; ++ks2)
#pragma unroll
                for (int st = 0; st < 4; ++st) { const bf16x8 b2f = *(const LAS bf16x8*)(B2 + (ks2 * 4 + st) * 1024 + lane * 16); y[st] = __builtin_amdgcn_mfma_f32_16x16x32_bf16(a2[ks2], b2f, y[st], 0, 0, 0); }
#pragma unroll
            for (int st = 0; st < 4; ++st) { u32x2 w; w.x = cvt_pk_bf16(y[st][0], y[st][1]); w.y = cvt_pk_bf16(y[st][2], y[st][3]); *(LAS u32x2*)(Yw + (16 * st + lr) * 68 + 16 * rb + 4 * lq) = w; }
        }
        __syncthreads();
#pragma unroll 2
        for (int it = 0; it < 8; ++it) { const int tp = tid + 512 * it, sp = tp >> 6, rp = tp & 63; unsigned short e[8];
#pragma unroll
            for (int w = 0; w < 8; ++w) e[w] = Yall[w * 4352 + sp * 68 + rp];
            u32x4 o; o.x = (unsigned)e[0] | ((unsigned)e[1] << 16); o.y = (unsigned)e[2] | ((unsigned)e[3] << 16); o.z = (unsigned)e[4] | ((unsigned)e[5] << 16); o.w = (unsigned)e[6] | ((unsigned)e[7] << 16);
            *(u32x4*)(CAT + (size_t)(NCTX + b * 4096 + tp) * 1024 + jg * 8) = o; }
        __syncthreads();
    }
}

__device__ __forceinline__ void router_phase(Frame& F, const Args& a, int l) {
    LAS unsigned char* wt = F.lds; LAS float* scr = (LAS float*)(F.lds + 131072 + F.wave * 2112); LAS unsigned* hist = (LAS unsigned*)(F.lds + 131072 + 16896);
    const int tid = F.tid, lane = F.lane, lr = lane & 15, lq = lane >> 4;
    { const u32x4* rt = (const u32x4*)(F.ws + WS_RT + (size_t)l * 131072); u32x4 tv[16];
#pragma unroll
      for (int i = 0; i < 16; ++i) tv[i] = rt[i * 512 + tid];
#pragma unroll
      for (int i = 0; i < 16; ++i) *(LAS u32x4*)(wt + (i * 512 + tid) * 16) = tv[i]; }
    if (tid < 32) hist[tid] = 0u;
    const float hsc = ((const float*)(F.ws + WS_HSC))[l * 2];
    __syncthreads();
    SUBSTAMP(F, l, 0);
    const int row_start = l ? NCTX : 0, ntask = (MT - row_start) / 16;
    const float* a12 = (const float*)(F.ws + WS_A12) + (size_t)(l * 2 + 1) * 17 * 1024; const float* modv = (const float*)(F.ws + WS_MODV) + (size_t)l * 17 * 6144;
    bf16* H = (bf16*)(F.ws + WS_H); int* tope = (int*)(F.ws + WS_TOPE); float* topg = (float*)(F.ws + WS_TOPG);
    const bf16* XB = (const bf16*)(F.ws + WS_XB); const float* ssp = (const float*)(F.ws + WS_SS);
    const float rb0 = a.in[I_RB][l * 32 + lr], rb1 = a.in[I_RB][l * 32 + 16 + lr];
    auto accumulate = [&](int task, int kb, int ke, f32x4& acc0, f32x4& acc1) {
        const int R0 = row_start + task * 16, row = R0 + lr, b = batch_of_row(R0);
        const bf16* xrow = XB + (size_t)row * 1024 + 8 * lq;
        const float* gp = a12 + (size_t)b * 1024 + 8 * lq; const float* sp = modv + (size_t)b * 6144 + 3072 + 8 * lq;
        float ss;
        { const f32x4* q = (const f32x4*)(ssp + (size_t)row * 16); const f32x4 s0 = q[0], s1 = q[1], s2 = q[2], s3 = q[3];
          ss = ((s0[0] + s0[1]) + (s0[2] + s0[3])) + ((s1[0] + s1[1]) + (s1[2] + s1[3])) + ((s2[0] + s2[1]) + (s2[2] + s2[3])) + ((s3[0] + s3[1]) + (s3[2] + s3[3])); }
        const float rn = rsqrtf(ss * (1.0f / 1024.0f) + NORM_EPS);
        acc0 = (f32x4){0.f, 0.f, 0.f, 0.f}; acc1 = acc0;
        unsigned char* h8row = F.ws + WS_H8 + (size_t)row * 1024 + 8 * lq;
        u32x4 xr[4];
#pragma unroll
        for (int u = 0; u < 4; ++u) xr[u] = *(const u32x4*)(xrow + 32 * (kb + u));
        for (int k4 = kb; k4 < ke; k4 += 4) {
            f32x4 xx[4][2], gg[4][2], sh[4][2]; u32x4 xn[4];
#pragma unroll
            for (int u = 0; u < 4; ++u) { const int ks = k4 + u;
                gg[u][0] = *(const f32x4*)(gp + 32 * ks); gg[u][1] = *(const f32x4*)(gp + 32 * ks + 4); sh[u][0] = *(const f32x4*)(sp + 32 * ks); sh[u][1] = *(const f32x4*)(sp + 32 * ks + 4); }
            { const int kn = (k4 + 4 < ke) ? k4 + 4 : k4;
#pragma unroll
              for (int u = 0; u < 4; ++u) xn[u] = *(const u32x4*)(xrow + 32 * (kn + u)); }
#pragma unroll
            for (int u = 0; u < 4; ++u) { const u32x4 w = xr[u]; xx[u][0] = (f32x4){bf_lo(w.x), bf_hi(w.x), bf_lo(w.y), bf_hi(w.y)}; xx[u][1] = (f32x4){bf_lo(w.z), bf_hi(w.z), bf_lo(w.w), bf_hi(w.w)}; }
#pragma unroll
            for (int u = 0; u < 4; ++u) { const int ks = k4 + u;
                const f32x4 h0 = xx[u][0] * rn * gg[u][0] + sh[u][0], h1 = xx[u][1] * rn * gg[u][1] + sh[u][1];
                const u32x4 hw = pack8(h0, h1);
                { u32x2 w8; w8.x = cvt4_fp8(h0[0] * hsc, h0[1] * hsc, h0[2] * hsc, h0[3] * hsc); w8.y = cvt4_fp8(h1[0] * hsc, h1[1] * hsc, h1[2] * hsc, h1[3] * hsc); *(u32x2*)(h8row + 32 * ks) = w8; }
                f32x4 l0, l1; l0[0] = h0[0] - bf_lo(hw.x); l0[1] = h0[1] - bf_hi(hw.x); l0[2] = h0[2] - bf_lo(hw.y); l0[3] = h0[3] - bf_hi(hw.y);
                l1[0] = h1[0] - bf_lo(hw.z); l1[1] = h1[1] - bf_hi(hw.z); l1[2] = h1[2] - bf_lo(hw.w); l1[3] = h1[3] - bf_hi(hw.w);
                const u32x4 lw = pack8(l0, l1);
                const bf16x8 ahi = __builtin_bit_cast(bf16x8, hw), alo = __builtin_bit_cast(bf16x8, lw);
                const bf16x8 b0h = *(const LAS bf16x8*)(wt + ((ks * 2 + 0) * 2 + 0) * 1024 + lane * 16), b0l = *(const LAS bf16x8*)(wt + ((ks * 2 + 0) * 2 + 1) * 1024 + lane * 16);
                const bf16x8 b1h = *(const LAS bf16x8*)(wt + ((ks * 2 + 1) * 2 + 0) * 1024 + lane * 16), b1l = *(const LAS bf16x8*)(wt + ((ks * 2 + 1) * 2 + 1) * 1024 + lane * 16);
                acc0 = __builtin_amdgcn_mfma_f32_16x16x32_bf16(ahi, b0h, acc0, 0, 0, 0); acc0 = __builtin_amdgcn_mfma_f32_16x16x32_bf16(ahi, b0l, acc0, 0, 0, 0); acc0 = __builtin_amdgcn_mfma_f32_16x16x32_bf16(alo, b0h, acc0, 0, 0, 0);
                acc1 = __builtin_amdgcn_mfma_f32_16x16x32_bf16(ahi, b1h, acc1, 0, 0, 0); acc1 = __builtin_amdgcn_mfma_f32_16x16x32_bf16(ahi, b1l, acc1, 0, 0, 0); acc1 = __builtin_amdgcn_mfma_f32_16x16x32_bf16(alo, b1h, acc1, 0, 0, 0); }
#pragma unroll
            for (int u = 0; u < 4; ++u) xr[u] = xn[u];
        }
    };
    auto route = [&](int task, const LAS float* src, int nsrc, int sstride) {
        if (lane < 16) {
            float v0 = -3.0e38f, v1 = -3.0e38f, v2 = -3.0e38f, v3 = -3.0e38f; int i0 = 0, i1 = 0, i2 = 0, i3 = 0;
#pragma unroll 4
            for (int e = 0; e < 32; ++e) { float x = src[lane * 33 + e]; for (int q = 1; q < nsrc; ++q) x += src[q * sstride + lane * 33 + e];
                if (x > v3) {
                    if (x > v0) { v3 = v2; i3 = i2; v2 = v1; i2 = i1; v1 = v0; i1 = i0; v0 = x; i0 = e; }
                    else if (x > v1) { v3 = v2; i3 = i2; v2 = v1; i2 = i1; v1 = x; i1 = e; }
                    else if (x > v2) { v3 = v2; i3 = i2; v2 = x; i2 = e; }
                    else { v3 = x; i3 = e; } } }
            const float e1 = __expf(v1 - v0), e2 = __expf(v2 - v0), e3 = __expf(v3 - v0), inv = 1.0f / (1.0f + e1 + e2 + e3);
            const int rr = row_start + task * 16 + lane;
            *(int4*)(tope + (size_t)rr * 4) = make_int4(i0, i1, i2, i3);
            *(f32x4*)(topg + (size_t)rr * 4) = (f32x4){inv, e1 * inv, e2 * inv, e3 * inv};
            lds_add(&hist[i0], 1u); lds_add(&hist[i1], 1u); lds_add(&hist[i2], 1u); lds_add(&hist[i3], 1u);
        }
    };
    const int NW = F.G * 8, nmain = (ntask / NW) * NW;
    for (int task = F.c * 8 + F.wave; task < nmain; task += NW) {
        f32x4 acc0, acc1; accumulate(task, 0, 32, acc0, acc1);
#pragma unroll
        for (int r = 0; r < 4; ++r) { scr[(4 * lq + r) * 33 + lr] = acc0[r] + rb0; scr[(4 * lq + r) * 33 + 16 + lr] = acc1[r] + rb1; }
        LDS_WAIT();
        route(task, scr, 1, 0);
        LDS_WAIT();
    }
    for (int task = nmain + F.c; task < ntask; task += F.G) {
        f32x4 acc0, acc1; accumulate(task, 4 * F.wave, 4 * F.wave + 4, acc0, acc1);
        const float c0 = F.wave == 0 ? rb0 : 0.f, c1 = F.wave == 0 ? rb1 : 0.f;
#pragma unroll
        for (int r = 0; r < 4; ++r) { scr[(4 * lq + r) * 33 + lr] = acc0[r] + c0; scr[(4 * lq + r) * 33 + 16 + lr] = acc1[r] + c1; }
        __syncthreads();
        if (F.wave == 0) route(task, (const LAS float*)(F.lds + 131072), 8, 528);
        __syncthreads();
    }
    SUBSTAMP(F, l, 1);
    LAS unsigned* lbase = hist + 32; LAS unsigned* lcur = hist + 64;
    asm volatile("s_waitcnt vmcnt(0)" ::: "memory");
    __syncthreads();
    if (tid < 32) { lbase[tid] = atomicAdd(F.ctl + CW_CUR + l * 64 + tid, hist[tid]); lcur[tid] = 0u; }
    __syncthreads();
    int* dest = (int*)(F.ws + WS_DEST); int* rlist = (int*)(F.ws + WS_RLIST);
    auto assign = [&](int task) { if (lane < 16) { const int rr = row_start + task * 16 + lane; const int4 ee = *(const int4*)(tope + (size_t)rr * 4); const int ev[4] = {ee.x, ee.y, ee.z, ee.w}; int dv[4];
#pragma unroll
            for (int k = 0; k < 4; ++k) { const unsigned pos = lbase[ev[k]] + lds_add(&lcur[ev[k]], 1u); rlist[(size_t)ev[k] * MT + pos] = rr; dv[k] = (ev[k] << 20) | (int)pos; }
            *(int4*)(dest + (size_t)rr * 4) = make_int4(dv[0], dv[1], dv[2], dv[3]); } };
    for (int task = F.c * 8 + F.wave; task < nmain; task += NW) assign(task);
    if (F.wave == 0) for (int task = nmain + F.c; task < ntask; task += F.G) assign(task);
}

__device__ __forceinline__ void dispatch_phase(Frame& F, int l) {
    LAS unsigned* L = (LAS unsigned*)F.lds;
    const int tid = F.tid;
    const int* tope = (const int*)(F.ws + WS_TOPE); int* dest = (int*)(F.ws + WS_DEST); int* rowmap = (int*)(F.ws + WS_ROWMAP); int* tile_e = (int*)(F.ws + WS_TILEE);
    if (tid < 32) { L[tid] = __hip_atomic_load(F.ctl + CW_CNT + l * 64 + tid, __ATOMIC_RELAXED, __HIP_MEMORY_SCOPE_AGENT); L[96 + tid] = 0u; L[128 + tid] = 0u; }
    __syncthreads();
    if (tid == 0) { unsigned off = 0; for (int e = 0; e < 32; ++e) { L[32 + e] = off; off += ((L[e] + 255u) >> 8) << 8; } L[64] = off; }
    __syncthreads();
    const int row_start = l ? NCTX : 0, nrows = MT - row_start, rpb = (nrows + F.G - 1) / F.G;
    const int r0 = row_start + F.c * rpb, r1 = (r0 + rpb < MT) ? r0 + rpb : MT, na = (r1 > r0 ? (r1 - r0) * 4 : 0);
    for (int i = tid; i < na; i += 512) lds_add(&L[96 + tope[(size_t)r0 * 4 + i]], 1u);
    __syncthreads();
    if (tid < 32) L[160 + tid] = atomicAdd(F.ctl + CW_CUR + l * 64 + tid, L[96 + tid]);
    __syncthreads();
    for (int i = tid; i < na; i += 512) { const int e = tope[(size_t)r0 * 4 + i]; const unsigned p = L[32 + e] + L[160 + e] + lds_add(&L[128 + e], 1u); rowmap[p] = r0 + (i >> 2); dest[(size_t)r0 * 4 + i] = (int)p; }
    if (F.c < 32) { const int e = F.c; const unsigned pe = L[32 + e] + L[e], pn = L[33 + e];
        for (unsigned p = pe + tid; p < pn; p += 512) rowmap[p] = row_start;
        for (unsigned t = (L[32 + e] >> 8) + tid; t < (pn >> 8); t += 512) tile_e[t] = e; }
    if (F.c == 0 && tid == 0) F.ctl[CW_NT + l * 64] = L[64] >> 8;
    __syncthreads();
}

typedef float f32x2v __attribute__((ext_vector_type(2)));
__device__ __forceinline__ void combine_phase(Frame& F, const Args& a, int l) {
    const int gw = F.c * 8 + F.wave, NGW = F.G * 8, lane = F.lane; constexpr int NR = 2;
    const LAS int* mtab = (const LAS int*)(F.lds + LDS_MOE);
    const int b32 = lane >> 1, esi = (b32 & 24) | ((b32 & 3) << 1) | ((b32 >> 2) & 1);
    const unsigned char* EOUT8 = F.ws + WS_EOUT8; const unsigned char* ES = F.ws + WS_ES; const int* dest = (const int*)(F.ws + WS_DEST); const float* topg = (const float*)(F.ws + WS_TOPG);
    const float* modv = (const float*)(F.ws + WS_MODV) + (size_t)l * 17 * 6144; bf16* XB = (bf16*)(F.ws + WS_XB); bf16* H = (bf16*)(F.ws + WS_H);
    const float* a12n = (const float*)(F.ws + WS_A12) + (size_t)(1 * 2 + 0) * 17 * 1024; const float* modvn = (const float*)(F.ws + WS_MODV) + (size_t)1 * 17 * 6144;
    for (int r0 = (l ? NCTX : 0) + gw * NR; r0 < MT; r0 += NGW * NR) {
        const int b = batch_of_row(r0);
        int4 d[NR]; f32x4 g[NR];
#pragma unroll
        for (int q = 0; q < NR; ++q) { d[q] = *(const int4*)(dest + (size_t)(r0 + q) * 4); g[q] = *(const f32x4*)(topg + (size_t)(r0 + q) * 4); }
        u32x4 ew[NR][4], xw[NR][2]; unsigned char sbv[NR][4]; f32x4 mg[4];
#pragma unroll
        for (int q = 0; q < NR; ++q) { const int dr[4] = {d[q].x, d[q].y, d[q].z, d[q].w}; int dd[4];
#pragma unroll
            for (int k = 0; k < 4; ++k) dd[k] = 256 * mtab[1152 + (dr[k] >> 20)] + (dr[k] & 0xFFFFF);
#pragma unroll
            for (int k = 0; k < 4; ++k) { ew[q][k] = *(const u32x4*)(EOUT8 + (size_t)dd[k] * 1024 + 16 * lane); sbv[q][k] = ES[(size_t)dd[k] * 32 + esi]; }
            xw[q][0] = *(const u32x4*)(XB + (size_t)(r0 + q) * 1024 + 16 * lane); xw[q][1] = *(const u32x4*)(XB + (size_t)(r0 + q) * 1024 + 16 * lane + 8); }
#pragma unroll
        for (int j = 0; j < 4; ++j) mg[j] = *(const f32x4*)(modv + (size_t)b * 6144 + 5120 + 16 * lane + 4 * j);
#pragma unroll
        for (int q = 0; q < NR; ++q) {
            f32x4 v[4]; float ss = 0.f;
#pragma unroll
            for (int j = 0; j < 4; ++j) v[j] = (f32x4){0.f, 0.f, 0.f, 0.f};
#pragma unroll
            for (int k = 0; k < 4; ++k) { const float sc = __uint_as_float((unsigned)sbv[q][k] << 23) * g[q][k]; const unsigned wv[4] = {ew[q][k].x, ew[q][k].y, ew[q][k].z, ew[q][k].w};
#pragma unroll
                for (int j = 0; j < 4; ++j) { const f32x2v lo = __builtin_amdgcn_cvt_pk_f32_fp8((int)wv[j], false), hi = __builtin_amdgcn_cvt_pk_f32_fp8((int)wv[j], true); v[j] += (f32x4){lo[0], lo[1], hi[0], hi[1]} * sc; } }
            const unsigned xv[8] = {xw[q][0].x, xw[q][0].y, xw[q][0].z, xw[q][0].w, xw[q][1].x, xw[q][1].y, xw[q][1].z, xw[q][1].w};
#pragma unroll
            for (int j = 0; j < 4; ++j) { v[j] = (f32x4){bf_lo(xv[2 * j]), bf_hi(xv[2 * j]), bf_lo(xv[2 * j + 1]), bf_hi(xv[2 * j + 1])} + mg[j] * v[j]; ss += (v[j][0] * v[j][0] + v[j][1] * v[j][1]) + (v[j][2] * v[j][2] + v[j][3] * v[j][3]); }
            const float rn = rsqrtf(wave_sum(ss) * (1.0f / 1024.0f) + NORM_EPS);
            if (l == 0) {
                const float* gain = a12n + (size_t)b * 1024 + 16 * lane; const float* shift = modvn + (size_t)b * 6144 + 16 * lane;
                *(u32x4*)(XB + (size_t)(r0 + q) * 1024 + 16 * lane) = pack8(v[0], v[1]); *(u32x4*)(XB + (size_t)(r0 + q) * 1024 + 16 * lane + 8) = pack8(v[2], v[3]);
                f32x4 hh[4];
#pragma unroll
                for (int j = 0; j < 4; ++j) hh[j] = v[j] * rn * *(const f32x4*)(gain + 4 * j) + *(const f32x4*)(shift + 4 * j);
                *(u32x4*)(H + (size_t)(r0 + q) * 1024 + 16 * lane) = pack8(hh[0], hh[1]); *(u32x4*)(H + (size_t)(r0 + q) * 1024 + 16 * lane + 8) = pack8(hh[2], hh[3]);
            } else {
                float* orow = a.out + (size_t)(r0 + q - NCTX) * 1024 + 16 * lane;
#pragma unroll
                for (int j = 0; j < 4; ++j) *(f32x4*)(orow + 4 * j) = v[j] * rn * *(const f32x4*)(a.in[I_FNW] + 16 * lane + 4 * j);
            }
        }
    }
}

__global__ void __launch_bounds__(512, 2) fwd_kernel(Args args) {
    extern __shared__ __attribute__((aligned(16))) unsigned char lds_raw[];
    Frame F;
    F.lds = (LAS unsigned char*)lds_raw; F.ws = args.ws; F.ctl = (unsigned*)(args.ws + WS_CTL);
    F.tid = threadIdx.x; F.lane = F.tid & 63; F.wave = __builtin_amdgcn_readfirstlane(F.tid >> 6); F.G = gridDim.x; F.c = blockIdx.x;
    volatile LAS unsigned* misc = (volatile LAS unsigned*)(F.lds + LDS_MISC);
    if (F.tid < 256) misc[F.tid] = 0u;
    __syncthreads();
    (void)xcd_barrier_post(F.ctl + CW_BAR, misc + 8);
#define GRID_BAR() do { size_t zb_ = 0; asm volatile("" : "+s"(zb_)); XcdBarrier bb_; bb_.bar = (unsigned*)(args.ws + zb_) + CW_BAR; bb_.x = xb_xcc_id(); bb_.st = (volatile LAS unsigned*)(F.lds + LDS_MISC) + 8; xcd_barrier(bb_); } while (0)
#if DIAG_A
    volatile LAS unsigned long long* tsl = (volatile LAS unsigned long long*)(F.lds + LDS_MISC + 64); int nst = 0;
#define STAMP() do { if (blockIdx.x == 0 && threadIdx.x == 0) tsl[nst] = wall_clock64(); ++nst; } while (0)
#else
#define STAMP() do {} while (0)
#endif
    STAMP();
#define FRESH() do { size_t z_ = 0; asm volatile("" : "+s"(z_)); F.ws = args.ws + z_; int t_ = threadIdx.x; asm volatile("" : "+v"(t_)); F.tid = t_; F.lane = t_ & 63; } while (0)

    for (int rep = 0; rep < DUP(0, 0); ++rep) { FRESH(); if (PH(0)) p0_prologue(F, args); }
    GRID_BAR(); STAMP();
    FRESH(); if (PH(1)) p0b_finalize(F, args);
    GRID_BAR(); STAMP();
    FRESH(); if (PH(1)) { p1_router_tables(F, args); p1_norm1_layer0(F, args); }
    GRID_BAR(); STAMP();

    for (int l = 0; l < 2; ++l) {
        for (int rep = 0; rep < DUP(2, l); ++rep) { FRESH(); if (PH(2)) { SchedInproj S{(const char*)(F.ws + WS_H), (const char*)(F.ws + WS_WQ) + (size_t)l * 2048 * 1024 * 2, (const char*)(F.ws + WS_WF) + (size_t)l * 1024 * 1024 * 2, F.G, F.c};
          EpiInproj E{(bf16*)(F.ws + WS_QKVG), (bf16*)(F.ws + WS_ZT), (bf16*)(F.ws + WS_ZTC), (const float*)(F.ws + WS_ROPE)};
          pg8::gemm_phase<EpiInproj, SchedInproj, false, true, true>(F.lds, 1024, S, E); } }
        GRID_BAR(); STAMP();
        for (int rep = 0; rep < DUP(3, l); ++rep) { FRESH(); if (PH(3)) retention_phase(F, args, l); }
        GRID_BAR(); STAMP();
        FRESH(); if (PH(4)) merge_phase(F, args, l); SUBSTAMP(F, l, 2);
        for (int rep = 0; rep < DUP(5, l); ++rep) { FRESH(); if (PH(5)) fft_phase(F); } SUBSTAMP(F, l, 3);
        FRESH(); if (PH(5) && l == 0) { SchedDftC S{(const char*)(F.ws + WS_DFTC), (const char*)(F.ws + WS_ZTC), F.G, F.c}; EpiCat E{(bf16*)(F.ws + WS_CAT), 0};
          pg8::gemm_phase<EpiCat, SchedDftC, false, true>(F.lds, 512, S, E); }
        GRID_BAR(); STAMP();
        for (int rep = 0; rep < DUP(6, l); ++rep) { FRESH(); if (PH(6)) { SchedReg S{(const char*)(F.ws + WS_CAT), (const char*)(F.ws + WS_WO) + (size_t)l * 1024 * 1024 * 2, l ? 256 : 272, 4, l ? 16 : 0, F.G, F.c, (size_t)256 * 1024 * 2};
          EpiRes E{args.in[I_X], args.in[I_CTX], (bf16*)(F.ws + WS_XB), (const float*)(F.ws + WS_MODV) + (size_t)l * 17 * 6144, (float*)(F.ws + WS_SS), l == 0 ? 1 : 0};
          pg8::gemm_phase<EpiRes, SchedReg, false, true>(F.lds, 1024, S, E); } }
        GRID_BAR(); STAMP();
        FRESH(); if (PH(7)) router_phase(F, args, l);
        GRID_BAR(); STAMP();
        FRESH(); const int nT = moe_tables(F, l);
        for (int rep = 0; rep < DUP(9, l); ++rep) { FRESH(); if (PH(9)) { SchedMoeQ S{(const char*)(F.ws + WS_H8), (const char*)(F.ws + WS_W1Q) + (size_t)l * 32 * 2048 * 1024, (const LAS int*)(F.lds + LDS_MOE), (const int*)(F.ws + WS_RLIST), l ? NCTX : 0, nT, 8, F.G, F.c, (size_t)2048 * 1024};
          const float hinv_ = __uint_as_float(__builtin_amdgcn_readfirstlane(__float_as_uint(((const float*)(F.ws + WS_HSC))[l * 2 + 1])));
          EpiW1Q E{F.ws + WS_ACT8, args.in[I_B1] + (size_t)l * 32 * 2048, (const float*)(F.ws + WS_W1CS) + (size_t)l * 32 * 2048, hinv_};
          pg8::gemm_phase_mx<EpiW1Q, SchedMoeQ, true>(F.lds, S, E); } }
        GRID_BAR(); STAMP();
        for (int rep = 0; rep < DUP(10, l); ++rep) { FRESH(); if (PH(10)) { SchedMoeQ S{(const char*)(F.ws + WS_ACT8), (const char*)(F.ws + WS_W2Q) + (size_t)l * 32 * 1024 * 1024, (const LAS int*)(F.lds + LDS_MOE), nullptr, 0, nT, 4, F.G, F.c, (size_t)1024 * 1024};
          EpiW2Q E{F.ws + WS_EOUT8, F.ws + WS_ES, args.in[I_B2] + (size_t)l * 32 * 1024, (const float*)(F.ws + WS_W2CS) + (size_t)l * 32 * 1024};
          pg8::gemm_phase_mx<EpiW2Q, SchedMoeQ, false>(F.lds, S, E); } }
        GRID_BAR(); STAMP();
        FRESH(); if (PH(11)) combine_phase(F, args, l);
        if (l == 0) { GRID_BAR(); STAMP(); }
    }
#if DIAG_A
    GRID_BAR(); STAMP();
    { if (threadIdx.x == 0 && blockIdx.x == 0) { ((float*)(args.ws + WS_MODP))[0] = (float)(tsl[DIAG_A] - tsl[DIAG_A0]) * 0.01f / (float)(DIAG_SA); ((float*)(args.ws + WS_MODP))[1] = (float)(tsl[DIAG_B] - tsl[DIAG_B0]) * 0.01f / (float)(DIAG_SB); }
      GRID_BAR();
      const float vA = ((volatile float*)(args.ws + WS_MODP))[0], vB = ((volatile float*)(args.ws + WS_MODP))[1];
      const size_t i = (size_t)blockIdx.x * 512 + threadIdx.x;
      if (i <= 65536) args.out[i] += (i == 0) ? vA : vB; }
#endif
}

extern "C" void kernel_launch(void* const* d_in, const int* in_sizes, int n_in, void* d_out, int out_size, void* d_ws, size_t ws_size, hipStream_t stream) {
    static int grid = 0;
    if (grid == 0) {
        if (n_in != 18 || out_size != NLAT * DM || ws_size < WS_END) { fprintf(stderr, "kernel_launch: unexpected shapes (n_in %d out %d ws %zu need %zu)\n", n_in, out_size, ws_size, (size_t)WS_END); grid = -1; return; }
        int dev = 0, cus = 0;
        if (hipGetDevice(&dev) != hipSuccess || hipDeviceGetAttribute(&cus, hipDeviceAttributeMultiprocessorCount, dev) != hipSuccess) { grid = -1; return; }
        if (hipFuncSetAttribute((const void*)fwd_kernel, hipFuncAttributeMaxDynamicSharedMemorySize, LDS_BYTES) != hipSuccess) { fprintf(stderr, "kernel_launch: hipFuncSetAttribute failed\n"); grid = -1; return; }
        int per_cu = 0;
        if (hipOccupancyMaxActiveBlocksPerMultiprocessor(&per_cu, (const void*)fwd_kernel, 512, LDS_BYTES) != hipSuccess || per_cu < 1) { fprintf(stderr, "kernel_launch: occupancy query says %d\n", per_cu); }
        (void)hipGetLastError();
        grid = cus;
    }
    if (grid < 0) return;
    (void)hipMemsetAsync((char*)d_ws + WS_CTL, 0, CTL_ZERO_BYTES, stream);
    Args a{};
    for (int i = 0; i < 18; ++i) a.in[i] = (const float*)d_in[i];
    a.out = (float*)d_out; a.ws = (unsigned char*)d_ws;
    hipLaunchKernelGGL(fwd_kernel, dim3(grid), dim3(512), LDS_BYTES, stream, a);
}
```
